# Optimizing an MI355X kernel written in HIP

```python
import math
import jax, jax.numpy as jnp
from jax import lax
import numpy as np

D_MODEL = 1024
BATCH = 2
SEQ = 8192
DEPTH = 2

CTX_LEN = 256
GRID_W = 64
HEAD_DIM = 64
ROPE_BASE = 10000.0
EPS = 1e-6
CHUNK = 128
D_RET = D_MODEL // 2
D_MLSTM = D_MODEL // 2
H_RET = D_RET // HEAD_DIM
H_MLSTM = D_MLSTM // HEAD_DIM
CONV_W = 3
AB_IN = 4 * D_RET + 4 * D_MLSTM + 4 * H_MLSTM
AB_SPLITS = tuple(int(s) for s in np.cumsum([D_RET] * 4 + [D_MLSTM] * 4))
H_ATTN = D_MODEL // HEAD_DIM
H_KV = 4
GQA_G = H_ATTN // H_KV
WINDOW = 128
BLK = 128
ATTN_IN = D_MODEL + 2 * H_KV * HEAD_DIM
D_FF = ((8 * D_MODEL // 3 + 255) // 256) * 256

kernel_name = 'hybrid_retention_mlstm_window_gqa_dit'


def _rmsnorm(x, w):
    xf = x.astype(jnp.float32)
    y = xf * lax.rsqrt(jnp.mean(xf * xf, axis=-1, keepdims=True) + EPS)
    return (y * w.astype(jnp.float32)).astype(x.dtype)


def _heads(x, h):
    return x.reshape(x.shape[0], x.shape[1], h, -1)


def _head_major(a):
    return jnp.transpose(a, (0, 2, 1, 3)).astype(jnp.float32)


def _axial_rope(L, dtype):
    rows = L // GRID_W
    row = jnp.repeat(jnp.arange(rows, dtype=jnp.float32), GRID_W)
    col = jnp.tile(jnp.arange(GRID_W, dtype=jnp.float32), rows)
    n = HEAD_DIM // 4
    inv = ROPE_BASE ** (-jnp.arange(n, dtype=jnp.float32) / n)
    ang = jnp.concatenate([row[:, None] * inv, col[:, None] * inv], axis=-1)
    return jnp.cos(ang).astype(dtype), jnp.sin(ang).astype(dtype)


def _apply_rope(x, cos, sin):
    half = x.shape[-1] // 2
    x1, x2 = x[..., :half], x[..., half:]
    c = cos[None, :, None, :]
    s = sin[None, :, None, :]
    return jnp.concatenate([x1 * c - x2 * s, x2 * c + x1 * s], axis=-1)


def _short_conv(x, w, b):
    L = x.shape[1]
    p = CONV_W // 2
    xp = jnp.pad(x, ((0, 0), (p, p), (0, 0)))
    y = b
    for j in range(CONV_W):
        y = y + w[j] * xp[:, j:j + L]
    return y


def _swiglu(h, w_in, w_out):
    g, u = jnp.split(h @ w_in, 2, axis=-1)
    return (jax.nn.silu(g) * u) @ w_out


def _retention_chunked(q, k, v, log_g, s0):
    B, H, L, dk = q.shape
    n = L // CHUNK
    k = k * dk ** -0.5
    qc = q.reshape(B, H, n, CHUNK, dk)
    kc = k.reshape(B, H, n, CHUNK, dk)
    vc = v.reshape(B, H, n, CHUNK, -1)
    pos = jnp.arange(CHUNK, dtype=jnp.float32)
    diff = pos[:, None] - pos[None, :]
    decay = jnp.where(diff >= 0, jnp.exp(log_g[:, None, None] * jnp.maximum(diff, 0.0)), 0.0)
    scores = jnp.einsum('bhnid,bhnjd->bhnij', qc, kc) * decay[None, :, None]
    intra = jnp.einsum('bhnij,bhnje->bhnie', scores, vc)
    k_dec = jnp.exp(log_g[:, None] * (CHUNK - 1.0 - pos))
    kv_local = jnp.einsum('bhnjd,hj,bhnje->nbhde', kc, k_dec, vc)
    chunk_decay = jnp.exp(log_g * CHUNK)[None, :, None, None]

    def step(s, kv):
        return chunk_decay * s + kv, s

    s_fin, s_prev = lax.scan(step, s0, kv_local)
    q_dec = jnp.exp(log_g[:, None] * (pos + 1.0))
    inter = jnp.einsum('bhnid,hi,nbhde->bhnie', qc, q_dec, s_prev)
    return (intra + inter).reshape(B, H, L, -1), s_fin


def _mlstm_chunked(q, k, v, i_pre, f_pre, state):
    B, H, L, d = q.shape
    n = L // CHUNK
    k = k * d ** -0.5
    qc = q.reshape(B, H, n, CHUNK, d)
    kc = k.reshape(B, H, n, CHUNK, d)
    vc = v.reshape(B, H, n, CHUNK, d)
    ic = i_pre.reshape(B, H, n, CHUNK)
    b = jnp.cumsum(jax.nn.log_sigmoid(f_pre).reshape(B, H, n, CHUNK), axis=-1)
    b_end = b[..., -1]
    causal = jnp.tril(jnp.ones((CHUNK, CHUNK), dtype=bool))
    d_log = jnp.where(causal, b[..., :, None] - b[..., None, :] + ic[..., None, :], -jnp.inf)
    g_end = b_end[..., None] - b + ic
    g_max = jnp.max(g_end, axis=-1)
    w_end = jnp.exp(g_end - g_max[..., None])
    kv_local = jnp.einsum('bhns,bhnsd,bhnse->nbhde', w_end, kc, vc)
    n_local = jnp.einsum('bhns,bhnsd->nbhd', w_end, kc)

    def step(carry, xs):
        c_mat, n_vec, m = carry
        kv, nl, gm, be = xs
        m_new = jnp.maximum(be + m, gm)
        a = jnp.exp(be + m - m_new)
        bb = jnp.exp(gm - m_new)
        c_new = a[..., None, None] * c_mat + bb[..., None, None] * kv
        n_new = a[..., None] * n_vec + bb[..., None] * nl
        return (c_new, n_new, m_new), (c_mat, n_vec, m)

    xs = (kv_local, n_local, jnp.moveaxis(g_max, 2, 0), jnp.moveaxis(b_end, 2, 0))
    final, (c_prev, n_prev, m_prev) = lax.scan(step, state, xs)
    m_prev = jnp.moveaxis(m_prev, 0, 2)
    a_log = b + m_prev[..., None]
    m_t = jnp.maximum(a_log, jnp.max(d_log, axis=-1))
    w = jnp.exp(d_log - m_t[..., None])
    a = jnp.exp(a_log - m_t)
    s = jnp.einsum('bhntd,bhnsd->bhnts', qc, kc) * w
    num = jnp.einsum('bhnts,bhnse->bhnte', s, vc) + a[..., None] * jnp.einsum('bhntd,nbhde->bhnte', qc, c_prev)
    den = jnp.sum(s, axis=-1) + a * jnp.einsum('bhntd,nbhd->bhnt', qc, n_prev)
    h = num / jnp.maximum(jnp.abs(den), jnp.exp(-m_t))[..., None]
    return h.reshape(B, H, L, d), final


def _sink_softmax(scores, sink):
    snk = sink[:, :, None]
    m = snk
    for s in scores:
        m = jnp.maximum(m, jnp.max(s, axis=-1))
    ex = [jnp.exp(s - m[..., None]) for s in scores]
    denom = jnp.exp(snk - m)
    for e in ex:
        denom = denom + jnp.sum(e, axis=-1)
    return [e / denom[..., None] for e in ex]


def _ret_mlstm_mixer(h, hc, rope, w_in, w_out, ret_log_gamma, ret_norm_w,
                     conv_w, conv_b, gate_b, mlstm_norm_w):
    f32 = jnp.float32
    B = h.shape[0]

    def prep(t, use_rope):
        rq, rk, rv, rg, mq, mk, mv, mo, mg = jnp.split(t @ w_in, AB_SPLITS, axis=-1)
        rq, rk, rv = _heads(rq, H_RET), _heads(rk, H_RET), _heads(rv, H_RET)
        if use_rope:
            rq, rk = rope(rq), rope(rk)
        mqk = jax.nn.silu(_short_conv(jnp.concatenate([mq, mk], axis=-1), conv_w, conv_b))
        mq, mk = jnp.split(mqk, 2, axis=-1)
        gates = (mg.astype(f32).reshape(t.shape[0], t.shape[1], 4, H_MLSTM)
                 + gate_b.astype(f32)).transpose(2, 0, 3, 1)
        ret = tuple(_head_major(a) for a in (rq, rk, rv))
        mls = tuple(_head_major(_heads(a, H_MLSTM)) for a in (mq, mk, mv))
        return ret, mls, gates, rg, mo

    ret_l, mls_l, gates_l, rg_l, mo_l = prep(h, True)
    ret_c, mls_c, gates_c, rg_c, mo_c = prep(hc, False)
    flip = lambda t: jnp.flip(t, axis=2)
    lg = ret_log_gamma.astype(f32)
    s0_r = jnp.zeros((B, H_RET, HEAD_DIM, HEAD_DIM), f32)
    s0_m = (jnp.zeros((B, H_MLSTM, HEAD_DIM, HEAD_DIM), f32),
            jnp.zeros((B, H_MLSTM, HEAD_DIM), f32),
            jnp.zeros((B, H_MLSTM), f32))

    def ret_dir(direction, ctx_args, lat_args):
        yc, s = _retention_chunked(*ctx_args, lg[direction], s0_r)
        yl, _ = _retention_chunked(*lat_args, lg[direction], s)
        return yc, yl

    def mls_dir(ctx_args, lat_args):
        yc, s = _mlstm_chunked(*ctx_args, s0_m)
        yl, _ = _mlstm_chunked(*lat_args, s)
        return yc, yl

    rc_f, rl_f = ret_dir(0, ret_c, ret_l)
    rc_b, rl_b = ret_dir(1, tuple(map(flip, ret_c)), tuple(map(flip, ret_l)))
    mc_f, ml_f = mls_dir((*mls_c, gates_c[0], gates_c[1]), (*mls_l, gates_l[0], gates_l[1]))
    mc_b, ml_b = mls_dir(tuple(map(flip, (*mls_c, gates_c[2], gates_c[3]))),
                         tuple(map(flip, (*mls_l, gates_l[2], gates_l[3]))))

    def merge(r, m, rg, mo, dtype):
        r = _rmsnorm(jnp.transpose(r, (0, 2, 1, 3)), ret_norm_w.reshape(H_RET, HEAD_DIM)).astype(dtype)
        r = r.reshape(r.shape[0], r.shape[1], D_RET) * jax.nn.silu(rg)
        m = _rmsnorm(jnp.transpose(m, (0, 2, 1, 3)), mlstm_norm_w.reshape(H_MLSTM, HEAD_DIM)).astype(dtype)
        m = m.reshape(m.shape[0], m.shape[1], D_MLSTM) * jax.nn.sigmoid(mo)
        return jnp.concatenate([r, m], axis=-1) @ w_out

    y_lat = merge(rl_f + flip(rl_b), ml_f + flip(ml_b), rg_l, mo_l, h.dtype)
    y_ctx = merge(rc_f + flip(rc_b), mc_f + flip(mc_b), rg_c, mo_c, hc.dtype)
    return y_lat, y_ctx


def _window_attn_mixer(h, hc, rope, w_in, w_out, q_norm_w, k_norm_w, sink, need_ctx_out):
    f32 = jnp.float32
    B, L, _ = h.shape
    nb = L // BLK
    scale = HEAD_DIM ** -0.5

    def prep(t):
        q, k, v = jnp.split(t @ w_in, [D_MODEL, D_MODEL + H_KV * HEAD_DIM], axis=-1)
        return (_rmsnorm(_heads(q, H_ATTN), q_norm_w), _rmsnorm(_heads(k, H_KV), k_norm_w), _heads(v, H_KV))

    q, k, v = prep(h)
    q, k = rope(q), rope(k)
    qc, kc, vc = prep(hc)
    snk = sink.astype(f32).reshape(H_KV, GQA_G)

    qb = q.reshape(B, nb, BLK, H_KV, GQA_G, HEAD_DIM)

    def band(t):
        tp = jnp.pad(t, ((0, 0), (BLK, BLK), (0, 0), (0, 0))).reshape(B, nb + 2, BLK, H_KV, HEAD_DIM)
        return jnp.concatenate([tp[:, :-2], tp[:, 1:-1], tp[:, 2:]], axis=2)

    kw, vw = band(k), band(v)
    s_win = jnp.einsum('bnqhgd,bnkhd->bnhgqk', qb, kw).astype(f32) * scale
    blk = jnp.arange(nb)[:, None, None]
    qpos = blk * BLK + jnp.arange(BLK)[None, :, None]
    kpos = (blk - 1) * BLK + jnp.arange(3 * BLK)[None, None, :]
    valid = (jnp.abs(qpos - kpos) <= WINDOW) & (kpos >= 0) & (kpos < L)
    s_win = jnp.where(valid[None, :, None, None], s_win, -jnp.inf)
    s_ctx = jnp.einsum('bnqhgd,bkhd->bnhgqk', qb, kc).astype(f32) * scale
    p_win, p_ctx = _sink_softmax([s_win, s_ctx], snk)
    o = (jnp.einsum('bnhgqk,bnkhd->bnqhgd', p_win.astype(v.dtype), vw)
         + jnp.einsum('bnhgqk,bkhd->bnqhgd', p_ctx.astype(vc.dtype), vc))
    y = o.reshape(B, L, D_MODEL) @ w_out
    if not need_ctx_out:
        return y, None
    Lc = hc.shape[1]
    qcg = qc.reshape(B, Lc, H_KV, GQA_G, HEAD_DIM)
    s_cc = jnp.einsum('bqhgd,bkhd->bhgqk', qcg, kc).astype(f32) * scale
    (p_cc,) = _sink_softmax([s_cc], snk)
    oc = jnp.einsum('bhgqk,bkhd->bqhgd', p_cc.astype(vc.dtype), vc).reshape(B, Lc, D_MODEL) @ w_out
    return y, oc


def setup_inputs(seed: int = 0) -> dict:
    key = jax.random.key(seed)
    ks = jax.random.split(key, 24)
    f32 = jnp.float32
    n_even = (DEPTH + 1) // 2
    n_odd = DEPTH // 2
    D = D_MODEL

    def nrm(k, shape, scale):
        return jax.random.normal(k, shape, f32) * scale

    base_lg = jnp.log1p(-jnp.exp2(-5.0 - jnp.arange(H_RET, dtype=f32)))
    fb = jnp.linspace(3.0, 6.0, H_MLSTM, dtype=f32)
    zb = jnp.zeros((H_MLSTM,), f32)
    gate_base = jnp.stack([zb, fb, zb, fb])
    return {
        'x': nrm(ks[0], (BATCH, SEQ, D), 1.0),
        'c': nrm(ks[1], (BATCH, D), 1.0),
        'ctx': nrm(ks[2], (BATCH, CTX_LEN, D), 1.0),
        'c_ctx': nrm(ks[3], (D,), 1.0),
        'ada_w': nrm(ks[4], (DEPTH, D, 6 * D), 0.5 * D ** -0.5),
        'ada_b': nrm(ks[5], (DEPTH, 6 * D), 0.02),
        'norm_w': 1.0 + nrm(ks[6], (DEPTH, 2, D), 0.02),
        'ffn_w_in': nrm(ks[7], (DEPTH, D, 2 * D_FF), D ** -0.5),
        'ffn_w_out': nrm(ks[8], (DEPTH, D_FF, D), D_FF ** -0.5),
        'ab_w_in': nrm(ks[9], (n_even, D, AB_IN), D ** -0.5),
        'ab_w_out': nrm(ks[10], (n_even, D_RET + D_MLSTM, D), (D_RET + D_MLSTM) ** -0.5),
        'ret_log_gamma': base_lg * (1.0 + nrm(ks[11], (n_even, 2, H_RET), 0.05)),
        'ret_norm_w': 1.0 + nrm(ks[12], (n_even, D_RET), 0.02),
        'mlstm_conv_w': nrm(ks[13], (n_even, CONV_W, 2 * D_MLSTM), CONV_W ** -0.5),
        'mlstm_conv_b': nrm(ks[14], (n_even, 2 * D_MLSTM), 0.02),
        'mlstm_gate_b': gate_base + nrm(ks[15], (n_even, 4, H_MLSTM), 0.1),
        'mlstm_norm_w': 1.0 + nrm(ks[16], (n_even, D_MLSTM), 0.02),
        'attn_w_in': nrm(ks[17], (n_odd, D, ATTN_IN), D ** -0.5),
        'attn_w_out': nrm(ks[18], (n_odd, D, D), D ** -0.5),
        'attn_q_norm_w': 1.0 + nrm(ks[19], (n_odd, HEAD_DIM), 0.02),
        'attn_k_norm_w': 1.0 + nrm(ks[20], (n_odd, HEAD_DIM), 0.02),
        'attn_sink': nrm(ks[21], (n_odd, H_ATTN), 0.5),
    }


def reference(x, c, ctx, c_ctx, ada_w, ada_b, norm_w, ffn_w_in, ffn_w_out, ab_w_in, ab_w_out,
              ret_log_gamma, ret_norm_w, mlstm_conv_w, mlstm_conv_b, mlstm_gate_b, mlstm_norm_w,
              attn_w_in, attn_w_out, attn_q_norm_w, attn_k_norm_w, attn_sink):
    L = x.shape[1]
    cos, sin = _axial_rope(L, x.dtype)
    rope = lambda t: _apply_rope(t, cos, sin)
    silu_c = jax.nn.silu(c)
    silu_cc = jax.nn.silu(c_ctx)
    for layer in range(DEPTH):
        last = layer == DEPTH - 1
        mod = (silu_c @ ada_w[layer] + ada_b[layer])[:, None, :]
        mod_c = (silu_cc @ ada_w[layer] + ada_b[layer])[None, None, :]
        sh1, sc1, g1, sh2, sc2, g2 = jnp.split(mod, 6, axis=-1)
        csh1, csc1, cg1, csh2, csc2, cg2 = jnp.split(mod_c, 6, axis=-1)
        h = _rmsnorm(x, norm_w[layer, 0]) * (1.0 + sc1) + sh1
        hc = _rmsnorm(ctx, norm_w[layer, 0]) * (1.0 + csc1) + csh1
        if layer % 2 == 0:
            e = layer // 2
            y, yc = _ret_mlstm_mixer(h, hc, rope, ab_w_in[e], ab_w_out[e], ret_log_gamma[e], ret_norm_w[e],
                                     mlstm_conv_w[e], mlstm_conv_b[e], mlstm_gate_b[e], mlstm_norm_w[e])
        else:
            o = layer // 2
            y, yc = _window_attn_mixer(h, hc, rope, attn_w_in[o], attn_w_out[o], attn_q_norm_w[o],
                                       attn_k_norm_w[o], attn_sink[o], not last)
        x = x + g1 * y
        x = x + g2 * _swiglu(_rmsnorm(x, norm_w[layer, 1]) * (1.0 + sc2) + sh2, ffn_w_in[layer], ffn_w_out[layer])
        if not last:
            ctx = ctx + cg1 * yc
            ctx = ctx + cg2 * _swiglu(_rmsnorm(ctx, norm_w[layer, 1]) * (1.0 + csc2) + csh2,
                                      ffn_w_in[layer], ffn_w_out[layer])
    return x
```

```cpp
#include <hip/hip_runtime.h>
#include <hip/hip_cooperative_groups.h>
#include <cstdio>
#include <cstdint>
namespace cg = cooperative_groups;

#ifndef REPEAT_MASK
#define REPEAT_MASK 0
#endif
#ifndef EXTRA_SYNCS
#define EXTRA_SYNCS 0
#endif
#ifndef MULTI_LAUNCH
#define MULTI_LAUNCH 0
#endif

typedef unsigned short bf16_t;
typedef short bf16x8 __attribute__((ext_vector_type(8)));
typedef float f32x16 __attribute__((ext_vector_type(16)));
#define DI __device__ __forceinline__
#define MFMA32(a, b, c) __builtin_amdgcn_mfma_f32_32x32x16_bf16((a), (b), (c), 0, 0, 0)

constexpr int SEQ = 8192, LC = 256, DM = 1024;
constexpr int NLAT = 2 * SEQ;
constexpr int MROWS = NLAT + 2 * LC;
constexpr int DFF = 2816;
constexpr int NCH = 66;
constexpr int LDT = 72;
constexpr int LDP = 136;
constexpr int LDV = 132;
typedef short s16x4 __attribute__((ext_vector_type(4)));
constexpr int HALF_SMEM = 80896;
constexpr int SMEM_BYTES = 2 * HALF_SMEM;
constexpr int NTHR = 512;
constexpr int LDS_TOTAL = SMEM_BYTES + 16;

constexpr size_t OFF_WIN0 = 0;
constexpr size_t OFF_WOUT0 = OFF_WIN0 + 4352ull * 1024 * 2;
constexpr size_t OFF_WFI = OFF_WOUT0 + 1024ull * 1024 * 2;
constexpr size_t OFF_WFO = OFF_WFI + 2ull * 5632 * 1024 * 2;
constexpr size_t OFF_WAI = OFF_WFO + 2ull * 1024 * 2816 * 2;
constexpr size_t OFF_WAO = OFF_WAI + 1536ull * 1024 * 2;
constexpr size_t OFF_MOD = OFF_WAO + 1024ull * 1024 * 2;
constexpr size_t OFF_ROPE = OFF_MOD + 2ull * 3 * 6144 * 4;
constexpr size_t OFF_NBUF = OFF_ROPE + 8192ull * 64 * 4;
constexpr size_t OFF_SCAL = OFF_NBUF + 64ull * 66 * 64 * 4;
constexpr size_t OFF_MPREV = OFF_SCAL + 64ull * 66 * 2 * 4;
constexpr size_t OFF_ARENA = (OFF_MPREV + 64ull * 66 * 4 + 255) & ~255ull;
constexpr size_t OFF_P0 = OFF_ARENA;
constexpr size_t OFF_GATES = OFF_P0 + (size_t)MROWS * 4096 * 2;
constexpr size_t OFF_SBUF = OFF_GATES + (size_t)MROWS * 32 * 4;
constexpr size_t OFF_X = OFF_ARENA;
constexpr size_t OFF_ACT = OFF_X + (size_t)MROWS * 1024 * 4;
constexpr size_t OFF_QKV = OFF_ACT;
constexpr size_t OFF_AO = OFF_QKV + (size_t)MROWS * 1536 * 2;
constexpr size_t OFF_BAR = (OFF_SBUF + 64ull * 66 * 4096 * 2 + 255) & ~255ull;
constexpr size_t OFF_XC = OFF_BAR + 16384;
constexpr size_t WS_END = OFF_XC + 512ull * 1024 * 4;

struct Params {
  const float* in[22];
  float* out;
  char* ws;
};
typedef const __attribute__((address_space(4))) Params* KP;

typedef float f32x2_t __attribute__((ext_vector_type(2)));
typedef __bf16 bf16x2_t __attribute__((ext_vector_type(2)));
DI unsigned pack2(float a, float b) { f32x2_t v = {a, b}; bf16x2_t r = __builtin_convertvector(v, bf16x2_t); return __builtin_bit_cast(unsigned, r); }
DI bf16_t f2bf(float x) { return (bf16_t)(pack2(x, x) & 0xffffu); }
DI float bf2f(bf16_t v) { return __uint_as_float(((unsigned)v) << 16); }
DI float sigmoidf_(float x) { return __builtin_amdgcn_rcpf(1.f + __expf(-x)); }
DI float siluf_(float x) { return x * __builtin_amdgcn_rcpf(1.f + __expf(-x)); }
DI float logsigf_(float x) { return fminf(x, 0.f) - __logf(1.f + __expf(-fabsf(x))); }
DI int lane_id() { int l; asm volatile("v_mbcnt_lo_u32_b32 %0, -1, 0\n\tv_mbcnt_hi_u32_b32 %0, -1, %0" : "=v"(l)); return l; }
template <int O> DI float swz(float v) { return __int_as_float(__builtin_amdgcn_ds_swizzle(__float_as_int(v), 0x1f | (O << 10))); }
template <int CTRL> DI float dpp(float v) { return __int_as_float(__builtin_amdgcn_update_dpp(0, __float_as_int(v), CTRL, 0xf, 0xf, true)); }
template <int O> DI float shx(float v) {
  if (O == 1) return dpp<0xB1>(v);
  if (O == 2) return dpp<0x4E>(v);
  return swz<O>(v);
}
DI float row16_max(float v) { v = fmaxf(v, dpp<0xB1>(v)); v = fmaxf(v, dpp<0x4E>(v)); v = fmaxf(v, dpp<0x141>(v)); v = fmaxf(v, dpp<0x140>(v)); return v; }
DI float row16_sum(float v) { v += dpp<0xB1>(v); v += dpp<0x4E>(v); v += dpp<0x141>(v); v += dpp<0x140>(v); return v; }
DI float shfl_lane(float v, int src) { return __int_as_float(__builtin_amdgcn_ds_bpermute(src << 2, __float_as_int(v))); }
DI int otid512(int wv) { int t = wv * 64 + lane_id(); asm volatile("" : "+v"(t)); return t; }
DI int otid(int wv) { return otid512(wv) & 255; }
template <int CTRL, int RMASK> DI float dpp_old(float old, float v) { return __int_as_float(__builtin_amdgcn_update_dpp(__float_as_int(old), __float_as_int(v), CTRL, RMASK, 0xf, false)); }
DI float wave_scan_sum(float v) {
  v += dpp_old<0x111, 0xf>(0.f, v); v += dpp_old<0x112, 0xf>(0.f, v); v += dpp_old<0x114, 0xf>(0.f, v); v += dpp_old<0x118, 0xf>(0.f, v);
  v += dpp_old<0x142, 0xa>(0.f, v);
  v += dpp_old<0x143, 0xc>(0.f, v);
  return v;
}
DI float wave_scan_max(float v) {
  const float ni = -INFINITY;
  v = fmaxf(v, dpp_old<0x111, 0xf>(ni, v)); v = fmaxf(v, dpp_old<0x112, 0xf>(ni, v)); v = fmaxf(v, dpp_old<0x114, 0xf>(ni, v)); v = fmaxf(v, dpp_old<0x118, 0xf>(ni, v));
  v = fmaxf(v, dpp_old<0x142, 0xa>(ni, v));
  v = fmaxf(v, dpp_old<0x143, 0xc>(ni, v));
  return v;
}
DI float wave_sum(float v) {
  v = row16_sum(v); v += swz<16>(v);
  v += shfl_lane(v, lane_id() ^ 32);
  return v;
}
DI float half_max(float v) { v = row16_max(v); return fmaxf(v, swz<16>(v)); }
DI float half_sum(float v) { v = row16_sum(v); return v + swz<16>(v); }
DI int crow(int i, int h) { return (i & 3) + 8 * (i >> 2) + 4 * h; }

DI void load8bf(const bf16_t* src, float* v) {
  uint4 u = *(const uint4*)src;
  v[0] = __uint_as_float(u.x << 16); v[1] = __uint_as_float(u.x & 0xffff0000u);
  v[2] = __uint_as_float(u.y << 16); v[3] = __uint_as_float(u.y & 0xffff0000u);
  v[4] = __uint_as_float(u.z << 16); v[5] = __uint_as_float(u.z & 0xffff0000u);
  v[6] = __uint_as_float(u.w << 16); v[7] = __uint_as_float(u.w & 0xffff0000u);
}
DI void load32bf(const bf16_t* src, float* v) {
#pragma unroll
  for (int q = 0; q < 4; ++q) load8bf(src + q * 8, v + q * 8);
}
DI void store32bf(bf16_t* dst, const float* v) {
#pragma unroll
  for (int q = 0; q < 4; ++q) {
    uint4 u;
    u.x = pack2(v[q * 8 + 0], v[q * 8 + 1]); u.y = pack2(v[q * 8 + 2], v[q * 8 + 3]);
    u.z = pack2(v[q * 8 + 4], v[q * 8 + 5]); u.w = pack2(v[q * 8 + 6], v[q * 8 + 7]);
    *(uint4*)(dst + q * 8) = u;
  }
}
DI void rope32(float* v, int half, const float* rr) {
#pragma unroll
  for (int q = 0; q < 8; ++q) {
    float4 c4 = *(const float4*)(rr + q * 4);
    float4 s4 = *(const float4*)(rr + 32 + q * 4);
    float cc[4] = {c4.x, c4.y, c4.z, c4.w}, ss[4] = {s4.x, s4.y, s4.z, s4.w};
#pragma unroll
    for (int j = 0; j < 4; ++j) {
      float x = v[q * 4 + j];
      float o = shx<1>(x);
      v[q * 4 + j] = half ? (x * cc[j] + o * ss[j]) : (x * cc[j] - o * ss[j]);
    }
  }
}
DI void conv_silu32(const bf16_t* rowp, bool hp, bool hn, const float* cw, const float* cb, float scale, float* v) {
#pragma unroll
  for (int q = 0; q < 4; ++q) {
    float x0[8], xm[8], xp[8];
    load8bf(rowp + q * 8, x0);
    if (hp) load8bf(rowp - 4096 + q * 8, xm); else {
#pragma unroll
      for (int j = 0; j < 8; ++j) xm[j] = 0.f; }
    if (hn) load8bf(rowp + 4096 + q * 8, xp); else {
#pragma unroll
      for (int j = 0; j < 8; ++j) xp[j] = 0.f; }
#pragma unroll
    for (int g = 0; g < 2; ++g) {
      float4 b4 = *(const float4*)(cb + q * 8 + g * 4);
      float4 w0 = *(const float4*)(cw + q * 8 + g * 4);
      float4 w1 = *(const float4*)(cw + 1024 + q * 8 + g * 4);
      float4 w2 = *(const float4*)(cw + 2048 + q * 8 + g * 4);
      float bb[4] = {b4.x, b4.y, b4.z, b4.w}, a0[4] = {w0.x, w0.y, w0.z, w0.w}, a1[4] = {w1.x, w1.y, w1.z, w1.w}, a2[4] = {w2.x, w2.y, w2.z, w2.w};
#pragma unroll
      for (int j = 0; j < 4; ++j) {
        int e = g * 4 + j;
        float y = bb[j] + a0[j] * xm[e] + a1[j] * x0[e] + a2[j] * xp[e];
        v[q * 8 + e] = siluf_(y) * scale;
      }
    }
  }
}

DI void prep_transpose(int wv, const float* __restrict__ src, int ldsrc, int nvalid, int mode, bf16_t* __restrict__ dst, int K, int n0, int k0, float* lds) {
  const int tid = otid(wv);
  const int n4 = (tid & 15) * 4, kq = tid >> 4;
  const int n = n0 + n4;
  const int col = mode == 1 ? (((n >> 7) & 1) * 2816 + (n >> 8) * 128 + (n & 127))
                : mode == 2 ? ((n & ~255) + ((n >> 5) & 3) * 64 + ((n >> 7) & 1) * 32 + (n & 31)) : n;
  const bool valid = n < nvalid;
#pragma unroll
  for (int sb = 0; sb < 4; ++sb) {
#pragma unroll
    for (int i = 0; i < 4; ++i) {
      const int kk = i * 16 + kq;
      float4 v = make_float4(0.f, 0.f, 0.f, 0.f);
      if (valid) v = *(const float4*)(src + (size_t)(k0 + sb * 64 + kk) * ldsrc + col);
      float* d = lds + sb * 4160 + kk * 65 + n4;
      d[0] = v.x; d[1] = v.y; d[2] = v.z; d[3] = v.w;
    }
  }
  __syncthreads();
  const int k8 = (tid & 7) * 8, nq = tid >> 3;
#pragma unroll
  for (int sb = 0; sb < 4; ++sb) {
#pragma unroll
    for (int i = 0; i < 2; ++i) {
      const int n2 = i * 32 + nq;
      const float* c = lds + sb * 4160 + k8 * 65 + n2;
      uint4 o;
      o.x = pack2(c[0], c[65]); o.y = pack2(c[130], c[195]); o.z = pack2(c[260], c[325]); o.w = pack2(c[390], c[455]);
      *(uint4*)&dst[(size_t)(n0 + n2) * K + k0 + sb * 64 + k8] = o;
    }
  }
  __syncthreads();
}

DI void prep_mod(int wv, KP p, int item, float* lds) {
  const int tid = otid(wv);
  const int layer = item / 192, cb = item % 192;
  float* sv = lds;
  for (int i = tid; i < 3072; i += 256) {
    int v = i >> 10, k = i & 1023;
    float x = (v < 2) ? p->in[1][v * 1024 + k] : p->in[3][k];
    sv[i] = x / (1.f + expf(-x));
  }
  __syncthreads();
  const int kq = tid >> 3, c4 = tid & 7;
  const float* W = p->in[4] + (size_t)layer * 1024 * 6144 + cb * 32 + c4 * 4;
  float acc[3][4];
#pragma unroll
  for (int v = 0; v < 3; ++v)
#pragma unroll
    for (int j = 0; j < 4; ++j) acc[v][j] = 0.f;
#pragma unroll 8
  for (int i = 0; i < 32; ++i) {
    int k = kq * 32 + i;
    float4 w = *(const float4*)(W + (size_t)k * 6144);
#pragma unroll
    for (int v = 0; v < 3; ++v) {
      float s_ = sv[v * 1024 + k];
      acc[v][0] += s_ * w.x; acc[v][1] += s_ * w.y; acc[v][2] += s_ * w.z; acc[v][3] += s_ * w.w;
    }
  }
  float* red = lds + 3072;
#pragma unroll
  for (int v = 0; v < 3; ++v)
#pragma unroll
    for (int j = 0; j < 4; ++j) red[(kq * 3 + v) * 32 + c4 * 4 + j] = acc[v][j];
  __syncthreads();
  if (tid < 96) {
    int v = tid >> 5, col = tid & 31;
    float s_ = p->in[5][layer * 6144 + cb * 32 + col];
    for (int q = 0; q < 32; ++q) s_ += red[(q * 3 + v) * 32 + col];
    ((float*)(p->ws + OFF_MOD))[(layer * 3 + v) * 6144 + cb * 32 + col] = s_;
  }
  __syncthreads();
}

DI void prep_rope(int wv, KP p, int item) {
  float* rope = (float*)(p->ws + OFF_ROPE);
#pragma unroll 1
  for (int i = 0; i < 16; ++i) {
    int e = item * 4096 + i * 256 + otid(wv);
    int t = e >> 5, j = e & 31;
    int row = t >> 6, col = t & 63;
    float inv = powf(10000.f, -(float)(j & 15) / 16.f);
    float ang = (float)(j < 16 ? row : col) * inv;
    rope[t * 64 + j] = cosf(ang);
    rope[t * 64 + 32 + j] = sinf(ang);
  }
}

DI void phase_prep_tr(int wv, KP p, int item, char* smem) {
  float* lds = (float*)smem;
  const float* src; int ld, nvalid, mode, K, tk; bf16_t* dst; int j = item;
  if (j < 64) { src = p->in[10]; ld = 1024; nvalid = 1024; mode = 0; K = 1024; tk = 4; dst = (bf16_t*)(p->ws + OFF_WOUT0); }
  else if ((j -= 64) < 704) { int l = j / 352; j -= l * 352; src = p->in[7] + (size_t)l * 1024 * 5632; ld = 5632; nvalid = 5632; mode = 1; K = 1024; tk = 4; dst = (bf16_t*)(p->ws + OFF_WFI) + (size_t)l * 5632 * 1024; }
  else if ((j -= 704) < 352) { int l = j / 176; j -= l * 176; src = p->in[8] + (size_t)l * 2816 * 1024; ld = 1024; nvalid = 1024; mode = 0; K = 2816; tk = 11; dst = (bf16_t*)(p->ws + OFF_WFO) + (size_t)l * 1024 * 2816; }
  else if ((j -= 352) < 96) { src = p->in[17]; ld = 1536; nvalid = 1536; mode = 2; K = 1024; tk = 4; dst = (bf16_t*)(p->ws + OFF_WAI); }
  else if ((j -= 96) < 64) { src = p->in[18]; ld = 1024; nvalid = 1024; mode = 0; K = 1024; tk = 4; dst = (bf16_t*)(p->ws + OFF_WAO); }
  else { j -= 64; src = p->in[9]; ld = 4128; nvalid = 4128; mode = 0; K = 1024; tk = 4; dst = (bf16_t*)(p->ws + OFF_WIN0); }
  int nt = j / tk, kt = j % tk;
  prep_transpose(wv, src, ld, nvalid, mode, dst, K, nt * 64, kt * 256, lds);
}
constexpr int N_PREP_TR = 272 + 64 + 704 + 352 + 96 + 64;

DI void norm_mod_item(int wv, const float* __restrict__ srcLat, const float* __restrict__ srcCtx, const float* __restrict__ nw,
                      const float* __restrict__ mod, int shOff, bf16_t* __restrict__ dst, int item, float* __restrict__ copyCtx = nullptr) {
  const int t512 = otid512(wv);
  const int w = t512 >> 6, lane = t512 & 63;
  const int row = item * 16 + w * 2;
  const float* src = row < NLAT ? srcLat + (size_t)row * 1024 : srcCtx + (size_t)(row - NLAT) * 1024;
  const int v = row < NLAT ? (row >> 13) : 2;
  const float* sh = mod + v * 6144 + shOff;
  const float* sc = sh + 1024;
  float4 x0[4], x1[4], w4[4], s4[4], h4[4];
#pragma unroll
  for (int i = 0; i < 4; ++i) { x0[i] = ((const float4*)src)[lane + 64 * i]; x1[i] = ((const float4*)(src + 1024))[lane + 64 * i]; }
#pragma unroll
  for (int i = 0; i < 4; ++i) { w4[i] = ((const float4*)nw)[lane + 64 * i]; s4[i] = ((const float4*)sc)[lane + 64 * i]; h4[i] = ((const float4*)sh)[lane + 64 * i]; }
  if (copyCtx != nullptr && row >= NLAT) {
#pragma unroll
    for (int i = 0; i < 4; ++i) { ((float4*)(copyCtx + (size_t)(row - NLAT) * 1024))[lane + 64 * i] = x0[i]; ((float4*)(copyCtx + (size_t)(row - NLAT + 1) * 1024))[lane + 64 * i] = x1[i]; }
  }
  float ss0 = 0.f, ss1 = 0.f;
#pragma unroll
  for (int i = 0; i < 4; ++i) {
    ss0 += x0[i].x * x0[i].x + x0[i].y * x0[i].y + x0[i].z * x0[i].z + x0[i].w * x0[i].w;
    ss1 += x1[i].x * x1[i].x + x1[i].y * x1[i].y + x1[i].z * x1[i].z + x1[i].w * x1[i].w;
  }
  ss0 = wave_sum(ss0); ss1 = wave_sum(ss1);
  const float r0 = rsqrtf(ss0 * (1.f / 1024.f) + 1e-6f), r1 = rsqrtf(ss1 * (1.f / 1024.f) + 1e-6f);
#pragma unroll
  for (int i = 0; i < 4; ++i) {
    const int c4 = lane + 64 * i;
    const float m0 = w4[i].x * (1.f + s4[i].x), m1 = w4[i].y * (1.f + s4[i].y), m2 = w4[i].z * (1.f + s4[i].z), m3 = w4[i].w * (1.f + s4[i].w);
    uint2 o;
    o.x = pack2(x0[i].x * r0 * m0 + h4[i].x, x0[i].y * r0 * m1 + h4[i].y);
    o.y = pack2(x0[i].z * r0 * m2 + h4[i].z, x0[i].w * r0 * m3 + h4[i].w);
    *(uint2*)(dst + (size_t)row * 1024 + c4 * 4) = o;
    o.x = pack2(x1[i].x * r1 * m0 + h4[i].x, x1[i].y * r1 * m1 + h4[i].y);
    o.y = pack2(x1[i].z * r1 * m2 + h4[i].z, x1[i].w * r1 * m3 + h4[i].w);
    *(uint2*)(dst + (size_t)(row + 1) * 1024 + c4 * 4) = o;
  }
}

enum { EPI_P0 = 0, EPI_RES = 1, EPI_SWIGLU = 2, EPI_STORE = 3, EPI_QKV = 4 };
struct EpiArgs {
  bf16_t* obf;
  int ldo;
  float* of32;
  float* of32c;
  const float* resLat;
  const float* resCtx;
  const float* gvec;
  const float* bias;
};

typedef float f32x4 __attribute__((ext_vector_type(4)));
constexpr int G_HT = 128 * 64;
DI int lds_byte(int r, int c) {
  int st = (r >> 4) * 2 + (c >> 5), rr = r & 15, cc = c & 31, ob = rr * 64 + cc * 2;
  return st * 1024 + (ob ^ (((ob >> 9) & 1) << 5));
}
DI void stage_rc(int b, int& R, int& C) {
  int st = b / 1024, sb = b % 1024, swz = sb ^ (((sb >> 9) & 1) << 5);
  R = (st >> 1) * 16 + swz / 64; C = (st & 1) * 32 + (swz % 64) / 2;
}

template <int EPI, bool SPLIT>
DI void gemm_phase(int wv, const bf16_t* __restrict__ A, const bf16_t* __restrict__ Bt, int M, int N, int K, const EpiArgs& ea, char* smem, int Mfull = -1, int ksplit = 1) {
  bf16_t* shm = (bf16_t*)smem;
#define SA(b, h) (shm + ((b) * 2 + (h)) * G_HT)
#define SB(b, h) (shm + (4 + (b) * 2 + (h)) * G_HT)
#define STAGE(P, BASE, br, kt) do { const long _g = (long)(br) * K + (long)(kt) * 64 + kofs; \
    _Pragma("unroll") for (int _i = 0; _i < 2; ++_i) { const int _b = tix * 16 + _i * 8192; \
      __builtin_amdgcn_global_load_lds((const unsigned*)((BASE) + _g + (long)srow[_i] * K + scol[_i]), \
        (__attribute__((address_space(3))) unsigned*)((char*)(P) + _b), 16, 0, 0); } } while (0)
#define LDA(dst, b, h) _Pragma("unroll") for (int m = 0; m < 4; ++m) _Pragma("unroll") for (int k = 0; k < 2; ++k) \
    dst[m][k] = *reinterpret_cast<const bf16x8*>((char*)SA(b, h) + lds_byte(wr * 64 + m * 16 + fr, k * 32 + fq * 8))
#define LDB(dst, b, h) _Pragma("unroll") for (int n = 0; n < 2; ++n) _Pragma("unroll") for (int k = 0; k < 2; ++k) \
    dst[n][k] = *reinterpret_cast<const bf16x8*>((char*)SB(b, h) + lds_byte(wc * 32 + n * 16 + fr, k * 32 + fq * 8))
#define MMA(ai, bj, At_, Bt_) do { __builtin_amdgcn_s_setprio(1); \
    _Pragma("unroll") for (int m = 0; m < 4; ++m) _Pragma("unroll") for (int n = 0; n < 2; ++n) _Pragma("unroll") for (int k = 0; k < 2; ++k) \
      acc[ai][bj][m][n] = __builtin_amdgcn_mfma_f32_16x16x32_bf16(Bt_[n][k], At_[m][k], acc[ai][bj][m][n], 0, 0, 0); \
    __builtin_amdgcn_s_setprio(0); } while (0)
#define WAIT_V(n) asm volatile("s_waitcnt vmcnt(" #n ")" ::: "memory")
#define WAIT_L(n) asm volatile("s_waitcnt lgkmcnt(" #n ")" ::: "memory")
#define BAR __builtin_amdgcn_s_barrier()
#define SCHED __builtin_amdgcn_sched_barrier(0)
  if (Mfull < 0) Mfull = M;
  const int nM = Mfull / 256, nN = N / 256, nwg = nM * nN;
  int nunits = nwg;
  if constexpr (SPLIT) nunits += ((M - Mfull) / 256) * nN * ksplit;
  int G = gridDim.x, Lb = blockIdx.x;
  asm volatile("" : "+s"(G), "+s"(Lb));
  for (int L = Lb; L < nunits; L += G) {
    const int tix = otid512(wv);
    const int wid = tix >> 6, lane = tix & 63, wr = wid >> 2, wc = wid & 3, fr = lane & 15, fq = lane >> 4;
    int srow[2], scol[2];
    stage_rc(tix * 16, srow[0], scol[0]);
    stage_rc(tix * 16 + 8192, srow[1], scol[1]);
    int brow, bcol, kofs = 0, nt = K / 64;
    bool split = false;
    if constexpr (SPLIT) split = L >= nwg;
    if (!split) {
      int wgid = L;
      { const int q = nwg / 8, r = nwg % 8, xcd = wgid % 8, off = wgid / 8; wgid = (xcd < r ? xcd * (q + 1) : r * (q + 1) + (xcd - r) * q) + off; }
      const int nig = 8 * nN, gid = wgid / nig, fm = gid * 8, gsz = (nM - fm) < 8 ? (nM - fm) : 8;
      const int pm = fm + ((wgid % nig) % gsz), pn = (wgid % nig) / gsz;
      brow = pm * 256; bcol = pn * 256;
    } else {
      const int u = L - nwg, ks = u % ksplit, tile = u / ksplit;
      brow = Mfull + (tile / nN) * 256; bcol = (tile % nN) * 256;
      nt = nt / ksplit; kofs = ks * nt * 64;
    }
    f32x4 acc[2][2][4][2];
#pragma unroll
    for (int a0 = 0; a0 < 2; ++a0)
#pragma unroll
      for (int a1 = 0; a1 < 2; ++a1)
#pragma unroll
        for (int a2 = 0; a2 < 4; ++a2)
#pragma unroll
          for (int a3 = 0; a3 < 2; ++a3) acc[a0][a1][a2][a3] = f32x4{0.f, 0.f, 0.f, 0.f};
    bf16x8 At[4][2], B0[2][2], B1[2][2];
    STAGE(SB(0, 0), Bt, bcol, 0); STAGE(SA(0, 0), A, brow, 0);
    STAGE(SB(0, 1), Bt, bcol + 128, 0); STAGE(SA(0, 1), A, brow + 128, 0);
    if (wr == 1) BAR;
    WAIT_V(4); BAR;
    STAGE(SB(1, 0), Bt, bcol, 1); STAGE(SA(1, 0), A, brow, 1); STAGE(SB(1, 1), Bt, bcol + 128, 1);
    WAIT_V(6); BAR;
    for (int t = 0; t < nt - 2; t += 2) {
      LDB(B0, 0, 0); SCHED; LDA(At, 0, 0); STAGE(SA(1, 1), A, brow + 128, t + 1);
      WAIT_L(8); BAR; WAIT_L(0); MMA(0, 0, At, B0); BAR; SCHED;
      LDB(B1, 0, 1); STAGE(SB(0, 0), Bt, bcol, t + 2);
      BAR; WAIT_L(0); MMA(0, 1, At, B1); BAR;
      LDA(At, 0, 1); STAGE(SA(0, 0), A, brow, t + 2);
      BAR; WAIT_L(0); MMA(1, 0, At, B0); BAR; SCHED;
      STAGE(SB(0, 1), Bt, bcol + 128, t + 2);
      WAIT_V(6); BAR; MMA(1, 1, At, B1); BAR;
      LDB(B0, 1, 0); SCHED; LDA(At, 1, 0); STAGE(SA(0, 1), A, brow + 128, t + 2);
      WAIT_L(8); BAR; WAIT_L(0); MMA(0, 0, At, B0); BAR; SCHED;
      LDB(B1, 1, 1); STAGE(SB(1, 0), Bt, bcol, t + 3);
      BAR; WAIT_L(0); MMA(0, 1, At, B1); BAR;
      LDA(At, 1, 1); STAGE(SA(1, 0), A, brow, t + 3);
      BAR; WAIT_L(0); MMA(1, 0, At, B0); BAR; SCHED;
      STAGE(SB(1, 1), Bt, bcol + 128, t + 3);
      WAIT_V(6); BAR; MMA(1, 1, At, B1); BAR;
    }
    { LDB(B0, 0, 0); LDA(At, 0, 0); STAGE(SA(1, 1), A, brow + 128, nt - 1);
      BAR; WAIT_L(0); MMA(0, 0, At, B0); BAR;
      LDB(B1, 0, 1); BAR; WAIT_L(0); MMA(0, 1, At, B1); BAR;
      LDA(At, 0, 1); WAIT_V(4); BAR; WAIT_L(0); MMA(1, 0, At, B0); MMA(1, 1, At, B1); BAR; }
    { LDB(B0, 1, 0); LDA(At, 1, 0); WAIT_V(2); BAR; WAIT_L(0); MMA(0, 0, At, B0); BAR;
      LDB(B1, 1, 1); WAIT_V(0); BAR; WAIT_L(0); MMA(0, 1, At, B1); BAR;
      LDA(At, 1, 1); BAR; WAIT_L(0); MMA(1, 0, At, B0); MMA(1, 1, At, B1); BAR; }
    if (wr == 0) BAR;
    float* obase = nullptr; const float* rbase = nullptr; const float* gv = nullptr;
    if (EPI == EPI_RES) {
      const bool isc = brow >= NLAT;
      obase = isc ? ea.of32c - (size_t)NLAT * 1024 : ea.of32;
      rbase = isc ? ea.resCtx - (size_t)NLAT * 1024 : ea.resLat;
      gv = ea.gvec + (isc ? 2 : (brow >> 13)) * 6144;
    }
#pragma unroll
    for (int ai = 0; ai < 2; ++ai)
#pragma unroll
      for (int m = 0; m < 4; ++m) {
        const int row = brow + ai * 128 + wr * 64 + m * 16 + fr;
        if (EPI == EPI_QKV) {
          float x[2][2][4];
#pragma unroll
          for (int bj = 0; bj < 2; ++bj)
#pragma unroll
            for (int n = 0; n < 2; ++n)
#pragma unroll
              for (int j = 0; j < 4; ++j) x[bj][n][j] = acc[ai][bj][m][n][j];
          if (bcol < 1280) {
            float ss = 0.f;
#pragma unroll
            for (int bj = 0; bj < 2; ++bj)
#pragma unroll
              for (int n = 0; n < 2; ++n)
#pragma unroll
                for (int j = 0; j < 4; ++j) ss += x[bj][n][j] * x[bj][n][j];
            ss += swz<16>(ss);
            ss += shfl_lane(ss, lane ^ 32);
            const float rstd = rsqrtf(ss * (1.f / 64.f) + 1e-6f);
            const float* nwp = (bcol < 1024 ? ea.bias : ea.gvec) + fq * 4;
            const float sc_ = bcol < 1024 ? 0.125f * 1.44269504f : 1.f;
            const bool dorope = row < NLAT;
            const float* rr = ea.resLat + (size_t)(row & 8191) * 64 + fq * 4;
#pragma unroll
            for (int n = 0; n < 2; ++n) {
              const float4 w1 = *(const float4*)(nwp + n * 16), w2 = *(const float4*)(nwp + 32 + n * 16);
              float4 c4 = make_float4(1.f, 1.f, 1.f, 1.f), s4 = make_float4(0.f, 0.f, 0.f, 0.f);
              if (dorope) { c4 = *(const float4*)(rr + n * 16); s4 = *(const float4*)(rr + 32 + n * 16); }
              const float wa[4] = {w1.x, w1.y, w1.z, w1.w}, wb[4] = {w2.x, w2.y, w2.z, w2.w}, cc[4] = {c4.x, c4.y, c4.z, c4.w}, sn[4] = {s4.x, s4.y, s4.z, s4.w};
#pragma unroll
              for (int j = 0; j < 4; ++j) {
                const float y1 = x[0][n][j] * rstd * wa[j], y2 = x[1][n][j] * rstd * wb[j];
                x[0][n][j] = (y1 * cc[j] - y2 * sn[j]) * sc_;
                x[1][n][j] = (y2 * cc[j] + y1 * sn[j]) * sc_;
              }
            }
          }
#pragma unroll
          for (int bj = 0; bj < 2; ++bj)
#pragma unroll
            for (int n = 0; n < 2; ++n) {
              uint2 o; o.x = pack2(x[bj][n][0], x[bj][n][1]); o.y = pack2(x[bj][n][2], x[bj][n][3]);
              *(uint2*)&ea.obf[(size_t)row * 1536 + bcol + wc * 64 + bj * 32 + n * 16 + fq * 4] = o;
            }
        } else if (EPI == EPI_SWIGLU) {
#pragma unroll
          for (int n = 0; n < 2; ++n) {
            const f32x4 g = acc[ai][0][m][n], u = acc[ai][1][m][n];
            uint2 o;
            o.x = pack2(siluf_(g[0]) * u[0], siluf_(g[1]) * u[1]);
            o.y = pack2(siluf_(g[2]) * u[2], siluf_(g[3]) * u[3]);
            *(uint2*)&ea.obf[(size_t)row * ea.ldo + (bcol >> 1) + wc * 32 + n * 16 + fq * 4] = o;
          }
        } else {
#pragma unroll
          for (int bj = 0; bj < 2; ++bj)
#pragma unroll
            for (int n = 0; n < 2; ++n) {
              const int col = bcol + bj * 128 + wc * 32 + n * 16 + fq * 4;
              const f32x4 val = acc[ai][bj][m][n];
              if (EPI == EPI_P0) {
                if (bcol < 4096) { uint2 o; o.x = pack2(val[0], val[1]); o.y = pack2(val[2], val[3]); *(uint2*)&ea.obf[(size_t)row * 4096 + col] = o; }
                else if (col < 4128) {
                  const float4 bb = *(const float4*)(ea.bias + (col - 4096));
                  float4 o; o.x = val[0] + bb.x; o.y = val[1] + bb.y; o.z = val[2] + bb.z; o.w = val[3] + bb.w;
                  *(float4*)(ea.of32 + (size_t)row * 32 + (col - 4096)) = o;
                }
              } else if (EPI == EPI_RES) {
                const float4 g = *(const float4*)(gv + col);
                float* op = obase + (size_t)row * 1024 + col;
                bool done = false;
                if constexpr (SPLIT) {
                  if (split) { unsafeAtomicAdd(op, g.x * val[0]); unsafeAtomicAdd(op + 1, g.y * val[1]); unsafeAtomicAdd(op + 2, g.z * val[2]); unsafeAtomicAdd(op + 3, g.w * val[3]); done = true; }
                }
                if (!done) {
                  const float4 rr = *(const float4*)(rbase + (size_t)row * 1024 + col);
                  float4 o; o.x = rr.x + g.x * val[0]; o.y = rr.y + g.y * val[1]; o.z = rr.z + g.z * val[2]; o.w = rr.w + g.w * val[3];
                  *(float4*)op = o;
                }
              } else {
                uint2 o; o.x = pack2(val[0], val[1]); o.y = pack2(val[2], val[3]);
                *(uint2*)&ea.obf[(size_t)row * ea.ldo + col] = o;
              }
            }
        }
      }
    WAIT_V(0);
  }
#undef SA
#undef SB
#undef STAGE
#undef LDA
#undef LDB
#undef MMA
}

DI void chunk_rows(int b, int cc, int& row0, int& pos0, int& slen) {
  if (cc < 2) { row0 = NLAT + b * LC + cc * 128; pos0 = cc * 128; slen = LC; }
  else { row0 = b * SEQ + (cc - 2) * 128; pos0 = (cc - 2) * 128; slen = SEQ; }
}
DI int seq_index(int dir, int cc) { return dir == 0 ? cc : (cc < 2 ? 1 - cc : 67 - cc); }

template <bool WITH_ROW>
DI void mlstm_vecs(const float* __restrict__ gates, int row0, int hd, int dir, int lane, float mprev,
                   float* cv, float* rowv, float* av, float* en, float* tot) {
  const int j0 = 2 * lane, j1 = j0 + 1;
  const int p0 = dir ? 127 - j0 : j0, p1 = dir ? 127 - j1 : j1;
  const float* g0 = gates + (size_t)(row0 + p0) * 32 + dir * 16 + hd;
  const float* g1 = gates + (size_t)(row0 + p1) * 32 + dir * 16 + hd;
  const float i0 = g0[0], f0 = g0[8], i1 = g1[0], f1 = g1[8];
  const float lf0 = logsigf_(f0), lf1 = logsigf_(f1);
  const float s = lf0 + lf1;
  const float incl = wave_scan_sum(s);
  const float excl = incl - s;
  const float b0 = excl + lf0, b1 = b0 + lf1;
  const float c0 = i0 - b0, c1 = i1 - b1;
  const float im = wave_scan_max(fmaxf(c0, c1));
  float em = shfl_lane(im, (lane - 1) & 63);
  if (lane == 0) em = -INFINITY;
  if (WITH_ROW) { cv[p0] = c0; cv[p1] = c1; }
  else { const float mxa = shfl_lane(im, 63); cv[p0] = __expf(c0 - mxa); cv[p1] = __expf(c1 - mxa); }
  if (WITH_ROW) {
    const float pm0 = fmaxf(em, c0), pm1 = im;
    const float al0 = b0 + mprev, al1 = b1 + mprev;
    const float mt0 = fmaxf(al0, b0 + pm0), mt1 = fmaxf(al1, b1 + pm1);
    rowv[p0] = b0 - mt0; rowv[p1] = b1 - mt1;
    av[p0] = __expf(al0 - mt0); av[p1] = __expf(al1 - mt1);
    en[p0] = __expf(-mt0); en[p1] = __expf(-mt1);
  }
  if (lane == 63) { tot[0] = incl; tot[1] = im; }
}

DI void load_qk_l0(KP p, int type, int hd, int is_k, int row, int pos, int slen, bool isLat, int half, float scale, float* v) {
  const bf16_t* P0 = (const bf16_t*)(p->ws + OFF_P0);
  if (type == 0) {
    load32bf(P0 + (size_t)row * 4096 + (is_k ? 512 : 0) + hd * 64 + half * 32, v);
    if (isLat) rope32(v, half, (const float*)(p->ws + OFF_ROPE) + (size_t)pos * 64);
#pragma unroll
    for (int i = 0; i < 32; ++i) v[i] *= scale;
  } else {
    const int ch = (is_k ? 512 : 0) + hd * 64 + half * 32;
    conv_silu32(P0 + (size_t)row * 4096 + 2048 + ch, pos > 0, pos < slen - 1, p->in[13] + ch, p->in[14] + ch, scale, v);
  }
}

DI void unpack8(const uint4 u, float* v) {
  v[0] = __uint_as_float(u.x << 16); v[1] = __uint_as_float(u.x & 0xffff0000u);
  v[2] = __uint_as_float(u.y << 16); v[3] = __uint_as_float(u.y & 0xffff0000u);
  v[4] = __uint_as_float(u.z << 16); v[5] = __uint_as_float(u.z & 0xffff0000u);
  v[6] = __uint_as_float(u.w << 16); v[7] = __uint_as_float(u.w & 0xffff0000u);
}
DI void raw_issue(const bf16_t* rowp, int type, bool hp, bool hn, uint4* a) {
  const uint4 z = make_uint4(0u, 0u, 0u, 0u);
#pragma unroll
  for (int q = 0; q < 4; ++q) a[q] = ((const uint4*)rowp)[q];
#pragma unroll
  for (int q = 0; q < 4; ++q) { a[4 + q] = z; a[8 + q] = z; }
  if (type == 1) {
    if (hp) {
#pragma unroll
      for (int q = 0; q < 4; ++q) a[4 + q] = ((const uint4*)(rowp - 4096))[q];
    }
    if (hn) {
#pragma unroll
      for (int q = 0; q < 4; ++q) a[8 + q] = ((const uint4*)(rowp + 4096))[q];
    }
  }
}
DI void raw_process(KP p, int type, int hd, int is_k, int pos, bool isLat, int half, float scale, const uint4* a, float* v) {
  if (type == 0) {
#pragma unroll
    for (int q = 0; q < 4; ++q) unpack8(a[q], v + q * 8);
    if (isLat) rope32(v, half, (const float*)(p->ws + OFF_ROPE) + (size_t)pos * 64);
#pragma unroll
    for (int i = 0; i < 32; ++i) v[i] *= scale;
  } else {
    const int ch = (is_k ? 512 : 0) + hd * 64 + half * 32;
    const float* cw = p->in[13] + ch; const float* cb = p->in[14] + ch;
#pragma unroll
    for (int q = 0; q < 4; ++q) {
      float x0[8], xm[8], xp[8];
      unpack8(a[q], x0); unpack8(a[4 + q], xm); unpack8(a[8 + q], xp);
#pragma unroll
      for (int g = 0; g < 2; ++g) {
        const float4 b4 = *(const float4*)(cb + q * 8 + g * 4);
        const float4 w0 = *(const float4*)(cw + q * 8 + g * 4);
        const float4 w1 = *(const float4*)(cw + 1024 + q * 8 + g * 4);
        const float4 w2 = *(const float4*)(cw + 2048 + q * 8 + g * 4);
        const float bb[4] = {b4.x, b4.y, b4.z, b4.w}, a0[4] = {w0.x, w0.y, w0.z, w0.w}, a1[4] = {w1.x, w1.y, w1.z, w1.w}, a2[4] = {w2.x, w2.y, w2.z, w2.w};
#pragma unroll
        for (int j = 0; j < 4; ++j) {
          const int e = g * 4 + j;
          const float y = bb[j] + a0[j] * xm[e] + a1[j] * x0[e] + a2[j] * xp[e];
          v[q * 8 + e] = siluf_(y) * scale;
        }
      }
    }
  }
}

DI void phase_kvlocal(int wv, KP p, int item, char* smem) {
  const int tid = otid(wv), lane = tid & 63, w = tid >> 6;
  const int cc = (item >> 1) % NCH, hh = (item & 1) * 8 + (((item >> 1) / NCH) & 7), b = (item >> 1) / (NCH * 8);
  const int type = hh >> 3, hd = hh & 7;
  int row0, pos0, slen; chunk_rows(b, cc, row0, pos0, slen);
  const bool isLat = cc >= 2;
  bf16_t* sKT = (bf16_t*)smem;
  bf16_t* sVT = sKT + 2 * 64 * LDP;
  float* wgt = (float*)(sVT + 64 * LDP);
  float* tot = wgt + 256;
  const float* gates = (const float*)(p->ws + OFF_GATES);
  if (type == 0) {
    const int dir = tid >> 7, t = tid & 127;
    const float lg = p->in[11][dir * 8 + hd];
    wgt[tid] = dir ? expf(lg * (float)t) : expf(lg * (float)(127 - t));
  } else {
    if (w < 2) mlstm_vecs<false>(gates, row0, hd, w, lane, 0.f, wgt + w * 128, nullptr, nullptr, nullptr, tot + w * 2);
  }
  __syncthreads();
  {
    const int t = tid >> 1, half = tid & 1;
    float kv[32];
    const bf16_t* P0 = (const bf16_t*)(p->ws + OFF_P0);
    const uint4* vp = (const uint4*)(P0 + (size_t)(row0 + t) * 4096 + (type ? 3072 : 1024) + hd * 64 + half * 32);
    const uint4 v0 = vp[0], v1 = vp[1], v2 = vp[2], v3 = vp[3];
    load_qk_l0(p, type, hd, 1, row0 + t, pos0 + t, slen, isLat, half, 0.125f, kv);
    const float w0 = wgt[t], w1 = wgt[128 + t];
#pragma unroll
    for (int i = 0; i < 32; ++i) {
      const int d = half * 32 + i;
      sKT[d * LDP + t] = f2bf(kv[i] * w0);
      sKT[64 * LDP + d * LDP + t] = f2bf(kv[i] * w1);
    }
#define V_SC3(q, vr) do { \
    sVT[(half * 32 + (q) * 8 + 0) * LDP + t] = (bf16_t)((vr).x & 0xffffu); sVT[(half * 32 + (q) * 8 + 1) * LDP + t] = (bf16_t)((vr).x >> 16); \
    sVT[(half * 32 + (q) * 8 + 2) * LDP + t] = (bf16_t)((vr).y & 0xffffu); sVT[(half * 32 + (q) * 8 + 3) * LDP + t] = (bf16_t)((vr).y >> 16); \
    sVT[(half * 32 + (q) * 8 + 4) * LDP + t] = (bf16_t)((vr).z & 0xffffu); sVT[(half * 32 + (q) * 8 + 5) * LDP + t] = (bf16_t)((vr).z >> 16); \
    sVT[(half * 32 + (q) * 8 + 6) * LDP + t] = (bf16_t)((vr).w & 0xffffu); sVT[(half * 32 + (q) * 8 + 7) * LDP + t] = (bf16_t)((vr).w >> 16); } while (0)
    V_SC3(0, v0); V_SC3(1, v1); V_SC3(2, v2); V_SC3(3, v3);
#undef V_SC3
  }
  __syncthreads();
  const int wm = w >> 1, wn = w & 1, r = lane & 31, h = lane >> 5;
  bf16_t* SB = (bf16_t*)(p->ws + OFF_SBUF);
#pragma unroll
  for (int dir = 0; dir < 2; ++dir) {
    f32x16 acc;
#pragma unroll
    for (int i = 0; i < 16; ++i) acc[i] = 0.f;
#pragma unroll
    for (int ks = 0; ks < 8; ++ks) {
      bf16x8 a = *(const bf16x8*)&sKT[dir * 64 * LDP + (wm * 32 + r) * LDP + ks * 16 + h * 8];
      bf16x8 bb = *(const bf16x8*)&sVT[(wn * 32 + r) * LDP + ks * 16 + h * 8];
      acc = MFMA32(a, bb, acc);
    }
    const int sq = ((type * 2 + dir) * 2 + b) * 8 + hd;
    const int si = seq_index(dir, cc);
    bf16_t* dst = SB + ((size_t)sq * NCH + si) * 4096 + (wn * 32 + r) * 64 + wm * 32 + 4 * h;
#pragma unroll
    for (int g = 0; g < 4; ++g) {
      uint2 o; o.x = pack2(acc[4 * g], acc[4 * g + 1]); o.y = pack2(acc[4 * g + 2], acc[4 * g + 3]);
      *(uint2*)(dst + 8 * g) = o;
    }
  }
  if (type == 1 && tid < 128) {
    const int dir = tid >> 6, d = tid & 63;
    const bf16_t* rowp = sKT + dir * 64 * LDP + d * LDP;
    float s = 0.f;
    for (int q = 0; q < 16; ++q) {
      float x[8]; load8bf(rowp + q * 8, x);
#pragma unroll
      for (int j = 0; j < 8; ++j) s += x[j];
    }
    const int sq = ((2 + dir) * 2 + b) * 8 + hd;
    const int si = seq_index(dir, cc);
    ((float*)(p->ws + OFF_NBUF))[((size_t)sq * NCH + si) * 64 + d] = s;
    if (d == 0) {
      float* sc = (float*)(p->ws + OFF_SCAL) + ((size_t)sq * NCH + si) * 2;
      sc[0] = tot[dir * 2] + tot[dir * 2 + 1];
      sc[1] = tot[dir * 2];
    }
  }
  __syncthreads();
}

DI void phase_scan(int wv, KP p, int item) {
  const int tid = otid(wv);
  const int sq = item / 17, blk = item % 17;
  const int type = sq >> 5, dir = (sq >> 4) & 1, hd = sq & 7;
  const float* scal = (const float*)(p->ws + OFF_SCAL) + (size_t)sq * NCH * 2;
  const float adec = type == 0 ? expf(p->in[11][dir * 8 + hd] * 128.f) : 0.f;
  float* mp = (float*)(p->ws + OFF_MPREV) + (size_t)sq * NCH;
  if (blk < 16) {
    bf16_t* ptr = (bf16_t*)(p->ws + OFF_SBUF) + (size_t)sq * NCH * 4096 + blk * 256 + tid;
    float st = 0.f, m = 0.f;
#pragma unroll 1
    for (int n0 = 0; n0 < NCH; n0 += 22) {
      float kv[22];
#pragma unroll
      for (int j = 0; j < 22; ++j) kv[j] = bf2f(ptr[(size_t)(n0 + j) * 4096]);
#pragma unroll
      for (int j = 0; j < 22; ++j) {
        const int n = n0 + j;
        float a, bb;
        if (type == 0) { a = adec; bb = 1.f; }
        else {
          const float gm = scal[n * 2], be = scal[n * 2 + 1];
          const float mn = fmaxf(be + m, gm);
          a = __expf(be + m - mn); bb = __expf(gm - mn);
          m = mn;
        }
        ptr[(size_t)n * 4096] = f2bf(st);
        st = a * st + bb * kv[j];
      }
    }
  } else {
    if (type == 0 || tid > 64) return;
    float* ptr = (float*)(p->ws + OFF_NBUF) + (size_t)sq * NCH * 64 + (tid & 63);
    const bool active = tid < 64, wm = tid == 64;
    float st = 0.f, m = 0.f;
#pragma unroll 1
    for (int n0 = 0; n0 < NCH; n0 += 22) {
      float kv[22];
#pragma unroll
      for (int j = 0; j < 22; ++j) kv[j] = active ? ptr[(size_t)(n0 + j) * 64] : 0.f;
#pragma unroll
      for (int j = 0; j < 22; ++j) {
        const int n = n0 + j;
        const float gm = scal[n * 2], be = scal[n * 2 + 1];
        const float mn = fmaxf(be + m, gm);
        const float a = __expf(be + m - mn), bb = __expf(gm - mn);
        if (wm) mp[n] = m;
        m = mn;
        if (active) ptr[(size_t)n * 64] = st;
        st = a * st + bb * kv[j];
      }
    }
  }
}

DI void phase_chunkout(int wv, KP p, int item, char* smem, bf16_t* __restrict__ MRG) {
  const int tid = otid(wv), lane = tid & 63, w = tid >> 6;
  const int cc = (item >> 1) % NCH, hh = (item & 1) * 8 + (((item >> 1) / NCH) & 7), b = (item >> 1) / (NCH * 8);
  const int type = hh >> 3, hd = hh & 7;
  int row0, pos0, slen; chunk_rows(b, cc, row0, pos0, slen);
  const bool isLat = cc >= 2;
  bf16_t* sQ = (bf16_t*)smem;
  bf16_t* sK = sQ + 128 * LDT;
  bf16_t* sVT = sK + 128 * LDT;
  bf16_t* sCT = sVT + 64 * LDP;
  float* vec = (float*)(sCT + 2 * 64 * LDT);
  float* rowv = vec;
  float* colv = vec + 256;
  float* av = vec + 512;
  float* en = vec + 768;
  float* qn = vec + 1024;
  float* rsum = vec + 1280;
  float* tot = vec + 1536;
  float* npv = vec + 1540;
  bf16_t* sP = (bf16_t*)smem;
  float* sO = (float*)smem;
  const bf16_t* P0 = (const bf16_t*)(p->ws + OFF_P0);
  const float* gates = (const float*)(p->ws + OFF_GATES);
#define SQD(dir) (((type * 2 + (dir)) * 2 + b) * 8 + hd)
#define SID(dir) seq_index((dir), cc)
  uint4 gr[4];
  {
    const int t = tid >> 1, half = tid & 1;
    const int d = tid >> 2, e0 = (tid & 3) * 16;
    const int pos = pos0 + t;
    const bool hp = pos > 0, hn = pos < slen - 1;
    const bf16_t* rowb = P0 + (size_t)(row0 + t) * 4096 + hd * 64 + half * 32;
    uint4 qr[12], kr[12], vr[4];
    uint4 cx00, cx01, cx10, cx11;
    raw_issue(rowb + (type ? 2048 : 0), type, hp, hn, qr);
    raw_issue(rowb + (type ? 2560 : 512), type, hp, hn, kr);
#pragma unroll
    for (int q = 0; q < 4; ++q) { vr[q] = ((const uint4*)(rowb + (type ? 3072 : 1024)))[q]; }
  if (type == 0) {
    const int dir = tid >> 7, t = tid & 127;
    const float lg = p->in[11][dir * 8 + hd];
    rowv[tid] = dir ? -lg * (float)t : lg * (float)t;
    colv[tid] = dir ? lg * (float)t : -lg * (float)t;
    av[tid] = dir ? expf(lg * (float)(128 - t)) : expf(lg * (float)(t + 1));
  } else {
    if (w < 2) {
      const float mprev = ((const float*)(p->ws + OFF_MPREV))[(size_t)SQD(w) * NCH + SID(w)];
      mlstm_vecs<true>(gates, row0, hd, w, lane, mprev, colv + w * 128, rowv + w * 128, av + w * 128, en + w * 128, tot + w * 2);
    } else if (w == 2) {
      const int dir = lane >> 5;
      const float* nb = (const float*)(p->ws + OFF_NBUF) + ((size_t)SQD(dir) * NCH + SID(dir)) * 64;
      const int d = (lane & 31) * 2;
      npv[dir * 64 + d] = nb[d]; npv[dir * 64 + d + 1] = nb[d + 1];
    }
  }
    __builtin_amdgcn_sched_barrier(0);
    float v[32];
    raw_process(p, type, hd, 0, pos, isLat, half, 1.f, qr, v);
    store32bf(sQ + t * LDT + half * 32, v);
    __builtin_amdgcn_sched_barrier(0);
    {
      const uint4* s0 = (const uint4*)((const bf16_t*)(p->ws + OFF_SBUF) + ((size_t)SQD(0) * NCH + SID(0)) * 4096 + d * 64 + e0);
      const uint4* s1 = (const uint4*)((const bf16_t*)(p->ws + OFF_SBUF) + ((size_t)SQD(1) * NCH + SID(1)) * 4096 + d * 64 + e0);
      cx00 = s0[0]; cx01 = s0[1]; cx10 = s1[0]; cx11 = s1[1];
    }
    __builtin_amdgcn_sched_barrier(0);
    raw_process(p, type, hd, 1, pos, isLat, half, 0.125f, kr, v);
    store32bf(sK + t * LDT + half * 32, v);
    __builtin_amdgcn_sched_barrier(0);
#pragma unroll
    for (int q = 0; q < 4; ++q) {
      const unsigned uu[4] = {vr[q].x, vr[q].y, vr[q].z, vr[q].w};
#pragma unroll
      for (int j = 0; j < 4; ++j) {
        sVT[(half * 32 + q * 8 + 2 * j) * LDV + t] = (bf16_t)(uu[j] & 0xffffu);
        sVT[(half * 32 + q * 8 + 2 * j + 1) * LDV + t] = (bf16_t)(uu[j] >> 16);
      }
    }
    {
      uint4* dp0 = (uint4*)(sCT + d * LDT + e0);
      uint4* dp1 = (uint4*)(sCT + 64 * LDT + d * LDT + e0);
      dp0[0] = cx00; dp0[1] = cx01; dp1[0] = cx10; dp1[1] = cx11;
    }
  }
  __syncthreads();
  const int r = lane & 31, h = lane >> 5;
  bf16x8 qa[4];
#pragma unroll
  for (int ks = 0; ks < 4; ++ks) qa[ks] = *(const bf16x8*)&sQ[(w * 32 + r) * LDT + ks * 16 + h * 8];
  f32x16 accS[4];
#pragma unroll
  for (int tn = 0; tn < 4; ++tn) {
#pragma unroll
    for (int i = 0; i < 16; ++i) accS[tn][i] = 0.f;
#pragma unroll
    for (int ks = 0; ks < 4; ++ks) {
      bf16x8 kk = *(const bf16x8*)&sK[(tn * 32 + r) * LDT + ks * 16 + h * 8];
      accS[tn] = MFMA32(kk, qa[ks], accS[tn]);
    }
  }
  if (type == 1) {
    const int dir = tid >> 7, t = tid & 127;
    float s = 0.f;
    for (int q = 0; q < 8; ++q) {
      float x[8]; load8bf(sQ + t * LDT + q * 8, x);
#pragma unroll
      for (int j = 0; j < 8; ++j) s += x[j] * npv[dir * 64 + q * 8 + j];
    }
    qn[tid] = s;
  }
  __syncthreads();
  f32x16 accSum[2];
#pragma unroll
  for (int i = 0; i < 16; ++i) { accSum[0][i] = 0.f; accSum[1][i] = 0.f; }
  const int ws = wv & 3;
  const int tq = w * 32 + r;
#pragma unroll 1
  for (int dir = 0; dir < 2; ++dir) {
    const float* cvp = colv + dir * 128;
    const bf16_t* ct = sCT + dir * 64 * LDT;
    const float rvt = rowv[dir * 128 + tq];
    const float at = av[dir * 128 + tq];
    f32x16 accD[2];
#pragma unroll
    for (int i = 0; i < 16; ++i) { accD[0][i] = 0.f; accD[1][i] = 0.f; }
#pragma unroll
    for (int ks = 0; ks < 4; ++ks) {
      bf16x8 c0 = *(const bf16x8*)&ct[r * LDT + ks * 16 + h * 8];
      bf16x8 c1 = *(const bf16x8*)&ct[(32 + r) * LDT + ks * 16 + h * 8];
      accD[0] = MFMA32(c0, qa[ks], accD[0]);
      accD[1] = MFMA32(c1, qa[ks], accD[1]);
    }
#pragma unroll
    for (int i = 0; i < 16; ++i) { accD[0][i] *= at; accD[1][i] *= at; }
    float lsum = 0.f;
    int tl = tq; asm volatile("" : "+v"(tl));
#pragma unroll
    for (int tn = 0; tn < 4; ++tn) {
      const bool dead = dir ? (tn < ws) : (tn > ws);
      if (dead) continue;
      float pe[16];
      if (tn == ws) {
#pragma unroll
        for (int i = 0; i < 16; ++i) {
          const int s = tn * 32 + crow(i, h);
          const bool ok = dir ? (s >= tl) : (s <= tl);
          pe[i] = ok ? accS[tn][i] * __expf(rvt + cvp[s]) : 0.f;
        }
      } else {
#pragma unroll
        for (int i = 0; i < 16; ++i) pe[i] = accS[tn][i] * __expf(rvt + cvp[tn * 32 + crow(i, h)]);
      }
#pragma unroll
      for (int i = 0; i < 16; ++i) lsum += pe[i];
#pragma unroll
      for (int st = 0; st < 2; ++st) {
        uint4 pk;
        pk.x = pack2(pe[8 * st + 0], pe[8 * st + 1]); pk.y = pack2(pe[8 * st + 2], pe[8 * st + 3]);
        pk.z = pack2(pe[8 * st + 4], pe[8 * st + 5]); pk.w = pack2(pe[8 * st + 6], pe[8 * st + 7]);
        const bf16x8 pb = __builtin_bit_cast(bf16x8, pk);
#pragma unroll
        for (int et = 0; et < 2; ++et) {
          const bf16_t* vp = sVT + (et * 32 + r) * LDV + tn * 32 + 16 * st + 4 * h;
          const s16x4 lo = *(const s16x4*)vp, hi = *(const s16x4*)(vp + 8);
          const bf16x8 va = __builtin_shufflevector(lo, hi, 0, 1, 2, 3, 4, 5, 6, 7);
          accD[et] = MFMA32(va, pb, accD[et]);
        }
      }
      __builtin_amdgcn_sched_barrier(0);
    }
    float inv = 1.f;
    if (type == 1) {
      const float rs = lsum + shfl_lane(lsum, lane ^ 32);
      const float d0 = rs + at * qn[dir * 128 + tq];
      inv = __builtin_amdgcn_rcpf(fmaxf(fabsf(d0), en[dir * 128 + tq]));
    }
#pragma unroll
    for (int i = 0; i < 16; ++i) { accSum[0][i] += accD[0][i] * inv; accSum[1][i] += accD[1][i] * inv; }
  }
  {
    const int tg = otid(wv);
    const uint4* gp = (const uint4*)(P0 + (size_t)(row0 + (tg >> 1)) * 4096 + (type ? 3584 : 1536) + hd * 64 + (tg & 1) * 32);
#pragma unroll
    for (int q = 0; q < 4; ++q) gr[q] = gp[q];
  }
#pragma unroll
  for (int i = 0; i < 16; ++i) {
    sO[tq * 65 + crow(i, h)] = accSum[0][i];
    sO[tq * 65 + 32 + crow(i, h)] = accSum[1][i];
  }
  __syncthreads();
  {
    const int t = tid >> 1, half = tid & 1;
    float o[32], g[32];
    float ss = 0.f;
#pragma unroll
    for (int i = 0; i < 32; ++i) { o[i] = sO[t * 65 + half * 32 + i]; ss += o[i] * o[i]; }
    ss += shx<1>(ss);
    const float rstd = rsqrtf(ss * (1.f / 64.f) + 1e-6f);
#pragma unroll
    for (int q = 0; q < 4; ++q) unpack8(gr[q], g + q * 8);
    const float* nw = (type ? p->in[16] : p->in[12]) + hd * 64 + half * 32;
#pragma unroll
    for (int i = 0; i < 32; ++i) {
      const float gt = type ? sigmoidf_(g[i]) : siluf_(g[i]);
      o[i] = o[i] * rstd * nw[i] * gt;
    }
    store32bf(MRG + (size_t)(row0 + t) * 1024 + type * 512 + hd * 64 + half * 32, o);
  }
  __syncthreads();
}

DI void load_qk_l1(const bf16_t* __restrict__ src, const float* __restrict__ nw, const float* __restrict__ ropeRow, bool doRope, int half, float scale, float* v) {
  load32bf(src, v);
  float ss = 0.f;
#pragma unroll
  for (int i = 0; i < 32; ++i) ss += v[i] * v[i];
  ss += shx<1>(ss);
  const float rstd = rsqrtf(ss * (1.f / 64.f) + 1e-6f);
#pragma unroll
  for (int q = 0; q < 8; ++q) {
    const float4 w4 = *(const float4*)(nw + half * 32 + q * 4);
    v[q * 4 + 0] *= rstd * w4.x; v[q * 4 + 1] *= rstd * w4.y; v[q * 4 + 2] *= rstd * w4.z; v[q * 4 + 3] *= rstd * w4.w;
  }
  if (doRope) rope32(v, half, ropeRow);
#pragma unroll
  for (int i = 0; i < 32; ++i) v[i] *= scale;
}


DI void phase_attn(int wv, KP p, int item, char* smem) {
  const int tid = otid(wv), lane = tid & 63, w = tid >> 6, r = lane & 31, h = lane >> 5;
  const int qb = item & 63, hq = (item >> 6) & 15, b = item >> 10;
  const int hkv = hq >> 2;
  constexpr int BUF_ELEMS = 128 * LDT + 64 * LDV;
  bf16_t* sbase = (bf16_t*)smem;
  const bf16_t* QKV = (const bf16_t*)(p->ws + OFF_QKV);
  const int t2 = tid >> 1, half = tid & 1;
  uint4 kr0 = make_uint4(0, 0, 0, 0), kr1 = kr0, kr2 = kr0, kr3 = kr0, vr0 = kr0, vr1 = kr0, vr2 = kr0, vr3 = kr0;
#define TILE_VALID(kt) ((kt) >= 3 || (qb - 1 + (kt) >= 0 && qb - 1 + (kt) < 64))
#define TILE_ROW0(kt) ((kt) < 3 ? b * SEQ + (qb - 1 + (kt)) * 128 : NLAT + b * LC + ((kt) - 3) * 128)
#define TILE_LOAD(kt) do { const uint4* kp_ = (const uint4*)(QKV + (size_t)(TILE_ROW0(kt) + t2) * 1536 + 1024 + hkv * 64 + half * 32); \
    kr0 = kp_[0]; kr1 = kp_[1]; kr2 = kp_[2]; kr3 = kp_[3]; vr0 = kp_[32]; vr1 = kp_[33]; vr2 = kp_[34]; vr3 = kp_[35]; } while (0)
#define V_SCATTER(q, vr) do { \
    sVT[(half * 32 + (q) * 8 + 0) * LDV + t2] = (bf16_t)((vr).x & 0xffffu); sVT[(half * 32 + (q) * 8 + 1) * LDV + t2] = (bf16_t)((vr).x >> 16); \
    sVT[(half * 32 + (q) * 8 + 2) * LDV + t2] = (bf16_t)((vr).y & 0xffffu); sVT[(half * 32 + (q) * 8 + 3) * LDV + t2] = (bf16_t)((vr).y >> 16); \
    sVT[(half * 32 + (q) * 8 + 4) * LDV + t2] = (bf16_t)((vr).z & 0xffffu); sVT[(half * 32 + (q) * 8 + 5) * LDV + t2] = (bf16_t)((vr).z >> 16); \
    sVT[(half * 32 + (q) * 8 + 6) * LDV + t2] = (bf16_t)((vr).w & 0xffffu); sVT[(half * 32 + (q) * 8 + 7) * LDV + t2] = (bf16_t)((vr).w >> 16); } while (0)
  if (TILE_VALID(0)) TILE_LOAD(0);
  bf16x8 qa[4];
  {
    const bf16_t* qp = QKV + (size_t)(b * SEQ + qb * 128 + w * 32 + r) * 1536 + hq * 64 + h * 8;
#pragma unroll
    for (int ks = 0; ks < 4; ++ks) qa[ks] = *(const bf16x8*)(qp + ks * 16);
  }
  float wqm = 0.f, wkm = 0.f;
  {
    const float a_ = fabsf(p->in[19][lane]), b_ = fabsf(p->in[20][lane]);
    wqm = row16_max(a_); wqm = fmaxf(wqm, swz<16>(wqm)); wqm = fmaxf(wqm, shfl_lane(wqm, lane ^ 32));
    wkm = row16_max(b_); wkm = fmaxf(wkm, swz<16>(wkm)); wkm = fmaxf(wkm, shfl_lane(wkm, lane ^ 32));
  }
  const float snk2 = p->in[21][hq] * 1.44269504f;
  const float cshift = fmaxf(8.f * 1.44269504f * wqm * wkm, snk2);
  float lsum;
  f32x16 accO[2];
  float zero_ = 0.f, ninit = -cshift;
  asm volatile("" : "+v"(zero_), "+v"(ninit));
  lsum = zero_;
#pragma unroll
  for (int i = 0; i < 16; ++i) { accO[0][i] = zero_; accO[1][i] = zero_; }
#pragma unroll 1
  for (int kt = 0; kt < 5; ++kt) {
    const bool valid = TILE_VALID(kt);
    bf16_t* sK = sbase + (kt & 1) * BUF_ELEMS;
    bf16_t* sVT = sK + 128 * LDT;
    if (valid) {
      uint4* kd = (uint4*)(sK + t2 * LDT + half * 32);
      kd[0] = kr0; kd[1] = kr1; kd[2] = kr2; kd[3] = kr3;
      V_SCATTER(0, vr0); V_SCATTER(1, vr1); V_SCATTER(2, vr2); V_SCATTER(3, vr3);
    }
    __syncthreads();
    if (kt + 1 < 5 && TILE_VALID(kt + 1)) TILE_LOAD(kt + 1);
    if (valid) {
      const bool edge = (kt == 0 || kt == 2);
      const int ws = wv & 3;
      int tl = w * 32 + r; asm volatile("" : "+v"(tl));
#pragma unroll 1
      for (int tn = 0; tn < 4; ++tn) {
        if ((kt == 0 && tn < ws) || (kt == 2 && tn > ws)) continue;
        const bool diag = edge && tn == ws;
        f32x16 acc;
#pragma unroll
        for (int i = 0; i < 16; ++i) acc[i] = ninit;
#pragma unroll
        for (int ks = 0; ks < 4; ++ks) {
          bf16x8 kk = *(const bf16x8*)&sK[(tn * 32 + r) * LDT + ks * 16 + h * 8];
          acc = MFMA32(kk, qa[ks], acc);
        }
        float pe[16];
        if (diag) {
#pragma unroll
          for (int i = 0; i < 16; ++i) {
            const int sl = tn * 32 + crow(i, h);
            const bool ok = (kt == 0) ? (sl >= tl) : (sl <= tl);
            pe[i] = ok ? __builtin_amdgcn_exp2f(acc[i]) : 0.f;
          }
        } else {
#pragma unroll
          for (int i = 0; i < 16; ++i) pe[i] = __builtin_amdgcn_exp2f(acc[i]);
        }
        float s8 = 0.f;
#pragma unroll
        for (int i = 0; i < 16; ++i) s8 += pe[i];
        lsum += s8;
#pragma unroll
        for (int st = 0; st < 2; ++st) {
          uint4 pk;
          pk.x = pack2(pe[8 * st + 0], pe[8 * st + 1]); pk.y = pack2(pe[8 * st + 2], pe[8 * st + 3]);
          pk.z = pack2(pe[8 * st + 4], pe[8 * st + 5]); pk.w = pack2(pe[8 * st + 6], pe[8 * st + 7]);
          const bf16x8 pb = __builtin_bit_cast(bf16x8, pk);
#pragma unroll
          for (int et = 0; et < 2; ++et) {
            const bf16_t* vp = sVT + (et * 32 + r) * LDV + tn * 32 + 16 * st + 4 * h;
            const s16x4 lo = *(const s16x4*)vp, hi = *(const s16x4*)(vp + 8);
            const bf16x8 va = __builtin_shufflevector(lo, hi, 0, 1, 2, 3, 4, 5, 6, 7);
            accO[et] = MFMA32(va, pb, accO[et]);
          }
        }
      }
    }
  }
  __syncthreads();
#undef TILE_VALID
#undef TILE_ROW0
#undef TILE_LOAD
#undef V_SCATTER
  const float ltot = lsum + shfl_lane(lsum, lane ^ 32);
  const float inv = 1.f / (ltot + __builtin_amdgcn_exp2f(snk2 - cshift));
  bf16_t* dst = (bf16_t*)(p->ws + OFF_AO) + (size_t)(b * SEQ + qb * 128 + w * 32 + r) * 1024 + hq * 64 + 4 * h;
#pragma unroll
  for (int et = 0; et < 2; ++et)
#pragma unroll
    for (int g = 0; g < 4; ++g) {
      uint2 o;
      o.x = pack2(accO[et][4 * g] * inv, accO[et][4 * g + 1] * inv);
      o.y = pack2(accO[et][4 * g + 2] * inv, accO[et][4 * g + 3] * inv);
      *(uint2*)(dst + et * 32 + 8 * g) = o;
    }
}

#define XB_TMO      128
#define XB_XCNT(j)  (256  + 64 * (j))
#define XB_XSUB(j)  (1280 + 64 * (j))
#define XB_XGEN(j)  (2304 + 64 * (j))
#define XB_TOP      3328
#define XB_TOPGEN   3392
#define XCD_BAR_WORDS 3456
#define XB_SPIN_CAP (1u << 18)
DI unsigned xb_ld(unsigned* p) { return __hip_atomic_load(p, __ATOMIC_RELAXED, __HIP_MEMORY_SCOPE_AGENT); }
DI unsigned xb_add(unsigned* p, unsigned v) { return __hip_atomic_fetch_add(p, v, __ATOMIC_RELAXED, __HIP_MEMORY_SCOPE_AGENT); }
DI unsigned xb_xcc_id() { return (unsigned)__builtin_amdgcn_s_getreg((3 << 11) | 20) & 0xFu; }
#define XB_SPIN(cond, bar) do { unsigned _sp = 0; while (cond) { __builtin_amdgcn_s_sleep(1); \
    if ((++_sp & 255u) == 0u) { if (xb_ld(&(bar)[XB_TMO])) break; if (_sp > XB_SPIN_CAP) { atomicAdd(&(bar)[XB_TMO], 1u); break; } } } } while (0)
DI void xcd_barrier_complete(unsigned* bar, unsigned x, unsigned& nloc, unsigned& nx) {
  const unsigned G = gridDim.x;
  unsigned sum, cnt, mine, sp = 0u;
  for (;;) {
    sum = 0u; cnt = 0u; mine = 0u;
#pragma unroll
    for (unsigned j = 0; j < 16; ++j) { const unsigned c = xb_ld(&bar[XB_XCNT(j)]); sum += c; cnt += (c > 0u) ? 1u : 0u; mine = (j == x) ? c : mine; }
    if (sum == G) break;
    __builtin_amdgcn_s_sleep(1);
    if ((++sp & 255u) == 0u) { if (xb_ld(&bar[XB_TMO])) break; if (sp > XB_SPIN_CAP) { atomicAdd(&bar[XB_TMO], 1u); break; } }
  }
  nloc = mine > 0u ? mine : 1u; nx = cnt > 0u ? cnt : 1u;
}
DI void xcd_barrier(int wv, unsigned* bar, volatile unsigned* st) {
  asm volatile("s_waitcnt vmcnt(0)" ::: "memory");
  __syncthreads();
  if (wv == 0 && lane_id() == 0) {
    const unsigned x = xb_xcc_id();
    __builtin_amdgcn_s_waitcnt(0);
    unsigned nloc = st[0], nx = st[1];
    if (nloc == 0u) { xcd_barrier_complete(bar, x, nloc, nx); st[0] = nloc; st[1] = nx; }
    const unsigned old = xb_add(&bar[XB_XSUB(x)], 1u);
    const unsigned gen = old / nloc;
    if (old + 1u == (gen + 1u) * nloc) {
      __builtin_amdgcn_fence(__ATOMIC_RELEASE, "agent");
      asm volatile("s_waitcnt vmcnt(0)" ::: "memory");
      const unsigned og = xb_add(&bar[XB_TOP], 1u);
      const unsigned tg = og / nx;
      if (og + 1u == (tg + 1u) * nx) xb_add(&bar[XB_TOPGEN], 1u);
      else XB_SPIN(xb_ld(&bar[XB_TOPGEN]) == tg, bar);
      __builtin_amdgcn_fence(__ATOMIC_ACQUIRE, "agent");
      xb_add(&bar[XB_XGEN(x)], 1u);
      asm volatile("s_waitcnt vmcnt(0)" ::: "memory");
    } else {
      XB_SPIN(xb_ld(&bar[XB_XGEN(x)]) == gen, bar);
      __builtin_amdgcn_fence(__ATOMIC_ACQUIRE, "agent");
      asm volatile("s_waitcnt vmcnt(0)" ::: "memory");
    }
  }
  __syncthreads();
}

constexpr int N_PHASES = 17;

#define PAIR_LOOP(NITEMS, CALL) for (int pr = B0; pr < (NITEMS) / 2; pr += G) { const int it = 2 * pr + hb; CALL; }

DI void run_phase(int wv, KP p, int ph, char* smem) {
  asm volatile("" : "+s"(p));
  int G = gridDim.x, B0 = blockIdx.x;
  asm volatile("" : "+s"(G), "+s"(B0));
  const int hb = wv >> 2;
  char* sm = smem + hb * HALF_SMEM;
  const float* mod0 = (const float*)(p->ws + OFF_MOD);
  const float* mod1 = mod0 + 3 * 6144;
  bf16_t* HB = (bf16_t*)p->out;
  float* X = (float*)(p->ws + OFF_X);
  float* XC = (float*)(p->ws + OFF_XC);
  bf16_t* ACT = (bf16_t*)(p->ws + OFF_ACT);
  EpiArgs ea{};
  switch (ph) {
    case 0:
      PAIR_LOOP(N_PREP_TR, phase_prep_tr(wv, p, it, sm));
      for (int pr = G - 1 - B0; pr < 384 / 2; pr += G) { const int it = 2 * pr + hb; prep_mod(wv, p, it, (float*)sm); }
      for (int pr = G - 1 - B0 - 192; pr >= 0 && pr < 64 / 2; pr += G) { const int it = 2 * pr + hb; prep_rope(wv, p, it); }
      break;
    case 1:
      for (int it = B0; it < MROWS / 16; it += G) norm_mod_item(wv, p->in[0], p->in[2], p->in[6], mod0, 0, HB, it, XC);
      break;
    case 2:
      ea.obf = (bf16_t*)(p->ws + OFF_P0); ea.of32 = (float*)(p->ws + OFF_GATES); ea.bias = p->in[15];
      gemm_phase<EPI_P0, false>(wv, HB, (const bf16_t*)(p->ws + OFF_WIN0), MROWS, 4352, 1024, ea, smem);
      break;
    case 3:
      PAIR_LOOP(2 * 16 * NCH, phase_kvlocal(wv, p, it, sm));
      break;
    case 4:
      PAIR_LOOP(64 * 17, phase_scan(wv, p, it));
      break;
    case 5:
      PAIR_LOOP(2 * 16 * NCH, phase_chunkout(wv, p, it, sm, HB));
      break;
    case 6:
      ea.of32 = X; ea.of32c = XC; ea.resLat = p->in[0]; ea.resCtx = p->in[2]; ea.gvec = mod0 + 2048;
      gemm_phase<EPI_RES, true>(wv, HB, (const bf16_t*)(p->ws + OFF_WOUT0), MROWS, 1024, 1024, ea, smem, NLAT, 4);
      break;
    case 7:
      for (int it = B0; it < MROWS / 16; it += G) norm_mod_item(wv, X, XC, p->in[6] + 1024, mod0, 3072, HB, it);
      break;
    case 8:
      ea.obf = ACT; ea.ldo = DFF;
      gemm_phase<EPI_SWIGLU, false>(wv, HB, (const bf16_t*)(p->ws + OFF_WFI), MROWS, 5632, 1024, ea, smem);
      break;
    case 9:
      ea.of32 = X; ea.of32c = XC; ea.resLat = X; ea.resCtx = XC; ea.gvec = mod0 + 5120;
      gemm_phase<EPI_RES, true>(wv, ACT, (const bf16_t*)(p->ws + OFF_WFO), MROWS, 1024, DFF, ea, smem, NLAT, 11);
      break;
    case 10:
      for (int it = B0; it < MROWS / 16; it += G) norm_mod_item(wv, X, XC, p->in[6] + 2048, mod1, 0, HB, it);
      break;
    case 11:
      ea.obf = (bf16_t*)(p->ws + OFF_QKV); ea.ldo = 1536; ea.bias = p->in[19]; ea.gvec = p->in[20]; ea.resLat = (const float*)(p->ws + OFF_ROPE);
      gemm_phase<EPI_QKV, false>(wv, HB, (const bf16_t*)(p->ws + OFF_WAI), MROWS, 1536, 1024, ea, smem);
      break;
    case 12:
      PAIR_LOOP(2048, phase_attn(wv, p, it, sm));
      break;
    case 13:
      ea.of32 = X; ea.resLat = X; ea.resCtx = X; ea.gvec = mod1 + 2048;
      gemm_phase<EPI_RES, false>(wv, (const bf16_t*)(p->ws + OFF_AO), (const bf16_t*)(p->ws + OFF_WAO), NLAT, 1024, 1024, ea, smem);
      break;
    case 14:
      for (int it = B0; it < NLAT / 16; it += G) norm_mod_item(wv, X, X, p->in[6] + 3072, mod1, 3072, HB, it);
      break;
    case 15:
      ea.obf = ACT; ea.ldo = DFF;
      gemm_phase<EPI_SWIGLU, false>(wv, HB, (const bf16_t*)(p->ws + OFF_WFI) + (size_t)5632 * 1024, NLAT, 5632, 1024, ea, smem);
      break;
    case 16:
      ea.of32 = p->out; ea.resLat = X; ea.resCtx = X; ea.gvec = mod1 + 5120;
      gemm_phase<EPI_RES, false>(wv, ACT, (const bf16_t*)(p->ws + OFF_WFO) + (size_t)1024 * DFF, NLAT, 1024, DFF, ea, smem);
      break;
    default: break;
  }
}

#ifndef CG_SYNCS
#define CG_SYNCS 1
#endif
__global__ void __launch_bounds__(NTHR, 2) mega_fwd(Params pargs, int ph_lo, int ph_hi) {
  extern __shared__ __attribute__((aligned(16))) char smem[];
  KP p = (KP)__builtin_amdgcn_kernarg_segment_ptr();
  const int wv = __builtin_amdgcn_readfirstlane((int)(threadIdx.x >> 6));
  volatile unsigned* st = (volatile unsigned*)(smem + SMEM_BYTES);
  {
    unsigned* bar = (unsigned*)(p->ws + OFF_BAR);
    if (wv == 0 && lane_id() == 0) { st[0] = 0u; st[1] = 0u; (void)xb_add(&bar[XB_XCNT(xb_xcc_id())], 1u); }
    __syncthreads();
  }
  for (int ph = ph_lo; ph < ph_hi; ++ph) {
    run_phase(wv, p, ph, smem);
#if REPEAT_MASK
    if ((REPEAT_MASK >> ph) & 1) { xcd_barrier(wv, (unsigned*)(p->ws + OFF_BAR), st); run_phase(wv, p, ph, smem); }
#endif
    if (ph + 1 < ph_hi) {
      if (ph - ph_lo < CG_SYNCS) cg::this_grid().sync();
      else xcd_barrier(wv, (unsigned*)(p->ws + OFF_BAR), st);
    }
#if EXTRA_SYNCS
    if (ph == 0) { for (int e = 0; e < EXTRA_SYNCS; ++e) xcd_barrier(wv, (unsigned*)(p->ws + OFF_BAR), st); }
#endif
  }
}

extern "C" void kernel_launch(void* const* d_in, const int* in_sizes, int n_in, void* d_out, int out_size, void* d_ws, size_t ws_size, hipStream_t stream) {
  static int grid_blocks = 0;
  if (grid_blocks == 0) {
    if (n_in != 22 || out_size != NLAT * DM || ws_size < WS_END)
      fprintf(stderr, "kernel_launch: unexpected shapes n_in %d out %d ws %zu (need %zu)\n", n_in, out_size, ws_size, (size_t)WS_END);
    int dev = 0, cus = 0, per_cu = 0;
    (void)hipGetDevice(&dev);
    (void)hipDeviceGetAttribute(&cus, hipDeviceAttributeMultiprocessorCount, dev);
    (void)hipFuncSetAttribute((const void*)mega_fwd, hipFuncAttributeMaxDynamicSharedMemorySize, LDS_TOTAL);
    (void)hipOccupancyMaxActiveBlocksPerMultiprocessor(&per_cu, (const void*)mega_fwd, NTHR, LDS_TOTAL);
    if (per_cu < 1) fprintf(stderr, "kernel_launch: occupancy query reports %d blocks per CU\n", per_cu);
    grid_blocks = cus;
    fprintf(stderr, "kernel_launch: cus %d per_cu %d grid %d\n", cus, per_cu, grid_blocks);
  }
  Params p{};
  for (int i = 0; i < 22; ++i) p.in[i] = (const float*)d_in[i];
  p.out = (float*)d_out;
  p.ws = (char*)d_ws;
  (void)hipMemsetAsync((char*)d_ws + OFF_BAR, 0, 16384, stream);
#if MULTI_LAUNCH
  for (int ph = 0; ph < N_PHASES; ++ph) {
    int lo = ph, hi = ph + 1;
    hipLaunchKernelGGL(mega_fwd, dim3(grid_blocks), dim3(NTHR), LDS_TOTAL, stream, p, lo, hi);
  }
#else
  int lo = 0, hi = N_PHASES;
  void* args[] = {&p, &lo, &hi};
  hipError_t e = hipLaunchCooperativeKernel((const void*)mega_fwd, dim3(grid_blocks), dim3(NTHR), args, LDS_TOTAL, stream);
  if (e != hipSuccess) fprintf(stderr, "cooperative launch failed: %s (grid %d)\n", hipGetErrorString(e), grid_blocks);
#endif
}
```

```cpp
#include <hip/hip_runtime.h>
#include <hip/hip_cooperative_groups.h>
#include <cstdio>
#include <cstdint>
namespace cg = cooperative_groups;

#ifndef REPEAT_MASK
#define REPEAT_MASK 0
#endif
#ifndef EXTRA_SYNCS
#define EXTRA_SYNCS 0
#endif
#ifndef MULTI_LAUNCH
#define MULTI_LAUNCH 0
#endif

typedef unsigned short bf16_t;
typedef short bf16x8 __attribute__((ext_vector_type(8)));
typedef float f32x16 __attribute__((ext_vector_type(16)));
#define DI __device__ __forceinline__
#define MFMA32(a, b, c) __builtin_amdgcn_mfma_f32_32x32x16_bf16((a), (b), (c), 0, 0, 0)

constexpr int SEQ = 8192, LC = 256, DM = 1024;
constexpr int NLAT = 2 * SEQ;
constexpr int MROWS = NLAT + 2 * LC;
constexpr int DFF = 2816;
constexpr int NCH = 66;
constexpr int LDT = 72;
constexpr int LDP = 136;
constexpr int LDV = 132;
typedef short s16x4 __attribute__((ext_vector_type(4)));
constexpr int HALF_SMEM = 80896;
constexpr int SMEM_BYTES = 2 * HALF_SMEM;
constexpr int NTHR = 512;
constexpr int LDS_TOTAL = SMEM_BYTES + 16;

constexpr size_t OFF_WIN0 = 0;
constexpr size_t OFF_WOUT0 = OFF_WIN0 + 4352ull * 1024 * 2;
constexpr size_t OFF_WFI = OFF_WOUT0 + 1024ull * 1024 * 2;
constexpr size_t OFF_WFO = OFF_WFI + 2ull * 5632 * 1024 * 2;
constexpr size_t OFF_WAI = OFF_WFO + 2ull * 1024 * 2816 * 2;
constexpr size_t OFF_WAO = OFF_WAI + 1536ull * 1024 * 2;
constexpr size_t OFF_MOD = OFF_WAO + 1024ull * 1024 * 2;
constexpr size_t OFF_ROPE = OFF_MOD + 2ull * 3 * 6144 * 4;
constexpr size_t OFF_NBUF = OFF_ROPE + 8192ull * 64 * 4;
constexpr size_t OFF_SCAL = OFF_NBUF + 64ull * 66 * 64 * 4;
constexpr size_t OFF_MPREV = OFF_SCAL + 64ull * 66 * 2 * 4;
constexpr size_t OFF_ARENA = (OFF_MPREV + 64ull * 66 * 4 + 255) & ~255ull;
constexpr size_t OFF_P0 = OFF_ARENA;
constexpr size_t OFF_GATES = OFF_P0 + (size_t)MROWS * 4096 * 2;
constexpr size_t OFF_SBUF = OFF_GATES + (size_t)MROWS * 32 * 4;
constexpr size_t OFF_X = OFF_ARENA;
constexpr size_t OFF_ACT = OFF_X + (size_t)MROWS * 1024 * 4;
constexpr size_t OFF_QKV = OFF_ACT;
constexpr size_t OFF_AO = OFF_QKV + (size_t)MROWS * 1536 * 2;
constexpr size_t OFF_BAR = (OFF_SBUF + 64ull * 66 * 4096 * 2 + 255) & ~255ull;
constexpr size_t OFF_XC = OFF_BAR + 16384;
constexpr size_t WS_END = OFF_XC + 512ull * 1024 * 4;

struct Params {
  const float* in[22];
  float* out;
  char* ws;
};
typedef const __attribute__((address_space(4))) Params* KP;

typedef float f32x2_t __attribute__((ext_vector_type(2)));
typedef __bf16 bf16x2_t __attribute__((ext_vector_type(2)));
DI unsigned pack2(float a, float b) { f32x2_t v = {a, b}; bf16x2_t r = __builtin_convertvector(v, bf16x2_t); return __builtin_bit_cast(unsigned, r); }
DI bf16_t f2bf(float x) { return (bf16_t)(pack2(x, x) & 0xffffu); }
DI float bf2f(bf16_t v) { return __uint_as_float(((unsigned)v) << 16); }
DI float sigmoidf_(float x) { return __builtin_amdgcn_rcpf(1.f + __expf(-x)); }
DI float siluf_(float x) { return x * __builtin_amdgcn_rcpf(1.f + __expf(-x)); }
DI float logsigf_(float x) { return fminf(x, 0.f) - __logf(1.f + __expf(-fabsf(x))); }
DI int lane_id() { int l; asm volatile("v_mbcnt_lo_u32_b32 %0, -1, 0\n\tv_mbcnt_hi_u32_b32 %0, -1, %0" : "=v"(l)); return l; }
template <int O> DI float swz(float v) { return __int_as_float(__builtin_amdgcn_ds_swizzle(__float_as_int(v), 0x1f | (O << 10))); }
template <int CTRL> DI float dpp(float v) { return __int_as_float(__builtin_amdgcn_update_dpp(0, __float_as_int(v), CTRL, 0xf, 0xf, true)); }
template <int O> DI float shx(float v) {
  if (O == 1) return dpp<0xB1>(v);
  if (O == 2) return dpp<0x4E>(v);
  return swz<O>(v);
}
DI float row16_max(float v) { v = fmaxf(v, dpp<0xB1>(v)); v = fmaxf(v, dpp<0x4E>(v)); v = fmaxf(v, dpp<0x141>(v)); v = fmaxf(v, dpp<0x140>(v)); return v; }
DI float row16_sum(float v) { v += dpp<0xB1>(v); v += dpp<0x4E>(v); v += dpp<0x141>(v); v += dpp<0x140>(v); return v; }
DI float shfl_lane(float v, int src) { return __int_as_float(__builtin_amdgcn_ds_bpermute(src << 2, __float_as_int(v))); }
DI int otid512(int wv) { int t = wv * 64 + lane_id(); asm volatile("" : "+v"(t)); return t; }
DI int otid(int wv) { return otid512(wv) & 255; }
template <int CTRL, int RMASK> DI float dpp_old(float old, float v) { return __int_as_float(__builtin_amdgcn_update_dpp(__float_as_int(old), __float_as_int(v), CTRL, RMASK, 0xf, false)); }
DI float wave_scan_sum(float v) {
  v += dpp_old<0x111, 0xf>(0.f, v); v += dpp_old<0x112, 0xf>(0.f, v); v += dpp_old<0x114, 0xf>(0.f, v); v += dpp_old<0x118, 0xf>(0.f, v);
  v += dpp_old<0x142, 0xa>(0.f, v);
  v += dpp_old<0x143, 0xc>(0.f, v);
  return v;
}
DI float wave_scan_max(float v) {
  const float ni = -INFINITY;
  v = fmaxf(v, dpp_old<0x111, 0xf>(ni, v)); v = fmaxf(v, dpp_old<0x112, 0xf>(ni, v)); v = fmaxf(v, dpp_old<0x114, 0xf>(ni, v)); v = fmaxf(v, dpp_old<0x118, 0xf>(ni, v));
  v = fmaxf(v, dpp_old<0x142, 0xa>(ni, v));
  v = fmaxf(v, dpp_old<0x143, 0xc>(ni, v));
  return v;
}
DI float wave_sum(float v) {
  v = row16_sum(v); v += swz<16>(v);
  v += shfl_lane(v, lane_id() ^ 32);
  return v;
}
DI float half_max(float v) { v = row16_max(v); return fmaxf(v, swz<16>(v)); }
DI float half_sum(float v) { v = row16_sum(v); return v + swz<16>(v); }
DI int crow(int i, int h) { return (i & 3) + 8 * (i >> 2) + 4 * h; }

DI void load8bf(const bf16_t* src, float* v) {
  uint4 u = *(const uint4*)src;
  v[0] = __uint_as_float(u.x << 16); v[1] = __uint_as_float(u.x & 0xffff0000u);
  v[2] = __uint_as_float(u.y << 16); v[3] = __uint_as_float(u.y & 0xffff0000u);
  v[4] = __uint_as_float(u.z << 16); v[5] = __uint_as_float(u.z & 0xffff0000u);
  v[6] = __uint_as_float(u.w << 16); v[7] = __uint_as_float(u.w & 0xffff0000u);
}
DI void load32bf(const bf16_t* src, float* v) {
#pragma unroll
  for (int q = 0; q < 4; ++q) load8bf(src + q * 8, v + q * 8);
}
DI void store32bf(bf16_t* dst, const float* v) {
#pragma unroll
  for (int q = 0; q < 4; ++q) {
    uint4 u;
    u.x = pack2(v[q * 8 + 0], v[q * 8 + 1]); u.y = pack2(v[q * 8 + 2], v[q * 8 + 3]);
    u.z = pack2(v[q * 8 + 4], v[q * 8 + 5]); u.w = pack2(v[q * 8 + 6], v[q * 8 + 7]);
    *(uint4*)(dst + q * 8) = u;
  }
}
DI void rope32(float* v, int half, const float* rr) {
#pragma unroll
  for (int q = 0; q < 8; ++q) {
    float4 c4 = *(const float4*)(rr + q * 4);
    float4 s4 = *(const float4*)(rr + 32 + q * 4);
    float cc[4] = {c4.x, c4.y, c4.z, c4.w}, ss[4] = {s4.x, s4.y, s4.z, s4.w};
#pragma unroll
    for (int j = 0; j < 4; ++j) {
      float x = v[q * 4 + j];
      float o = shx<1>(x);
      v[q * 4 + j] = half ? (x * cc[j] + o * ss[j]) : (x * cc[j] - o * ss[j]);
    }
  }
}
DI void conv_silu32(const bf16_t* rowp, bool hp, bool hn, const float* cw, const float* cb, float scale, float* v) {
#pragma unroll
  for (int q = 0; q < 4; ++q) {
    float x0[8], xm[8], xp[8];
    load8bf(rowp + q * 8, x0);
    if (hp) load8bf(rowp - 4096 + q * 8, xm); else {
#pragma unroll
      for (int j = 0; j < 8; ++j) xm[j] = 0.f; }
    if (hn) load8bf(rowp + 4096 + q * 8, xp); else {
#pragma unroll
      for (int j = 0; j < 8; ++j) xp[j] = 0.f; }
#pragma unroll
    for (int g = 0; g < 2; ++g) {
      float4 b4 = *(const float4*)(cb + q * 8 + g * 4);
      float4 w0 = *(const float4*)(cw + q * 8 + g * 4);
      float4 w1 = *(const float4*)(cw + 1024 + q * 8 + g * 4);
      float4 w2 = *(const float4*)(cw + 2048 + q * 8 + g * 4);
      float bb[4] = {b4.x, b4.y, b4.z, b4.w}, a0[4] = {w0.x, w0.y, w0.z, w0.w}, a1[4] = {w1.x, w1.y, w1.z, w1.w}, a2[4] = {w2.x, w2.y, w2.z, w2.w};
#pragma unroll
      for (int j = 0; j < 4; ++j) {
        int e = g * 4 + j;
        float y = bb[j] + a0[j] * xm[e] + a1[j] * x0[e] + a2[j] * xp[e];
        v[q * 8 + e] = siluf_(y) * scale;
      }
    }
  }
}

DI void prep_transpose(int wv, const float* __restrict__ src, int ldsrc, int nvalid, int mode, bf16_t* __restrict__ dst, int K, int n0, int k0, float* lds) {
  const int tid = otid(wv);
  const int n4 = (tid & 15) * 4, kq = tid >> 4;
  const int n = n0 + n4;
  const int col = mode == 1 ? (((n >> 7) & 1) * 2816 + (n >> 8) * 128 + (n & 127))
                : mode == 2 ? ((n & ~255) + ((n >> 5) & 3) * 64 + ((n >> 7) & 1) * 32 + (n & 31)) : n;
  const bool valid = n < nvalid;
#pragma unroll
  for (int sb = 0; sb < 4; ++sb) {
#pragma unroll
    for (int i = 0; i < 4; ++i) {
      const int kk = i * 16 + kq;
      float4 v = make_float4(0.f, 0.f, 0.f, 0.f);
      if (valid) v = *(const float4*)(src + (size_t)(k0 + sb * 64 + kk) * ldsrc + col);
      float* d = lds + sb * 4160 + kk * 65 + n4;
      d[0] = v.x; d[1] = v.y; d[2] = v.z; d[3] = v.w;
    }
  }
  __syncthreads();
  const int k8 = (tid & 7) * 8, nq = tid >> 3;
#pragma unroll
  for (int sb = 0; sb < 4; ++sb) {
#pragma unroll
    for (int i = 0; i < 2; ++i) {
      const int n2 = i * 32 + nq;
      const float* c = lds + sb * 4160 + k8 * 65 + n2;
      uint4 o;
      o.x = pack2(c[0], c[65]); o.y = pack2(c[130], c[195]); o.z = pack2(c[260], c[325]); o.w = pack2(c[390], c[455]);
      *(uint4*)&dst[(size_t)(n0 + n2) * K + k0 + sb * 64 + k8] = o;
    }
  }
  __syncthreads();
}

DI void prep_mod(int wv, KP p, int item, float* lds) {
  const int tid = otid(wv);
  const int layer = item / 192, cb = item % 192;
  float* sv = lds;
  for (int i = tid; i < 3072; i += 256) {
    int v = i >> 10, k = i & 1023;
    float x = (v < 2) ? p->in[1][v * 1024 + k] : p->in[3][k];
    sv[i] = x / (1.f + expf(-x));
  }
  __syncthreads();
  const int kq = tid >> 3, c4 = tid & 7;
  const float* W = p->in[4] + (size_t)layer * 1024 * 6144 + cb * 32 + c4 * 4;
  float acc[3][4];
#pragma unroll
  for (int v = 0; v < 3; ++v)
#pragma unroll
    for (int j = 0; j < 4; ++j) acc[v][j] = 0.f;
#pragma unroll 8
  for (int i = 0; i < 32; ++i) {
    int k = kq * 32 + i;
    float4 w = *(const float4*)(W + (size_t)k * 6144);
#pragma unroll
    for (int v = 0; v < 3; ++v) {
      float s_ = sv[v * 1024 + k];
      acc[v][0] += s_ * w.x; acc[v][1] += s_ * w.y; acc[v][2] += s_ * w.z; acc[v][3] += s_ * w.w;
    }
  }
  float* red = lds + 3072;
#pragma unroll
  for (int v = 0; v < 3; ++v)
#pragma unroll
    for (int j = 0; j < 4; ++j) red[(kq * 3 + v) * 32 + c4 * 4 + j] = acc[v][j];
  __syncthreads();
  if (tid < 96) {
    int v = tid >> 5, col = tid & 31;
    float s_ = p->in[5][layer * 6144 + cb * 32 + col];
    for (int q = 0; q < 32; ++q) s_ += red[(q * 3 + v) * 32 + col];
    ((float*)(p->ws + OFF_MOD))[(layer * 3 + v) * 6144 + cb * 32 + col] = s_;
  }
  __syncthreads();
}

DI void prep_rope(int wv, KP p, int item) {
  float* rope = (float*)(p->ws + OFF_ROPE);
#pragma unroll 1
  for (int i = 0; i < 16; ++i) {
    int e = item * 4096 + i * 256 + otid(wv);
    int t = e >> 5, j = e & 31;
    int row = t >> 6, col = t & 63;
    float inv = powf(10000.f, -(float)(j & 15) / 16.f);
    float ang = (float)(j < 16 ? row : col) * inv;
    rope[t * 64 + j] = cosf(ang);
    rope[t * 64 + 32 + j] = sinf(ang);
  }
}

DI void phase_prep_tr(int wv, KP p, int item, char* smem) {
  float* lds = (float*)smem;
  const float* src; int ld, nvalid, mode, K, tk; bf16_t* dst; int j = item;
  if (j < 64) { src = p->in[10]; ld = 1024; nvalid = 1024; mode = 0; K = 1024; tk = 4; dst = (bf16_t*)(p->ws + OFF_WOUT0); }
  else if ((j -= 64) < 704) { int l = j / 352; j -= l * 352; src = p->in[7] + (size_t)l * 1024 * 5632; ld = 5632; nvalid = 5632; mode = 1; K = 1024; tk = 4; dst = (bf16_t*)(p->ws + OFF_WFI) + (size_t)l * 5632 * 1024; }
  else if ((j -= 704) < 352) { int l = j / 176; j -= l * 176; src = p->in[8] + (size_t)l * 2816 * 1024; ld = 1024; nvalid = 1024; mode = 0; K = 2816; tk = 11; dst = (bf16_t*)(p->ws + OFF_WFO) + (size_t)l * 1024 * 2816; }
  else if ((j -= 352) < 96) { src = p->in[17]; ld = 1536; nvalid = 1536; mode = 2; K = 1024; tk = 4; dst = (bf16_t*)(p->ws + OFF_WAI); }
  else if ((j -= 96) < 64) { src = p->in[18]; ld = 1024; nvalid = 1024; mode = 0; K = 1024; tk = 4; dst = (bf16_t*)(p->ws + OFF_WAO); }
  else { j -= 64; src = p->in[9]; ld = 4128; nvalid = 4128; mode = 0; K = 1024; tk = 4; dst = (bf16_t*)(p->ws + OFF_WIN0); }
  int nt = j / tk, kt = j % tk;
  prep_transpose(wv, src, ld, nvalid, mode, dst, K, nt * 64, kt * 256, lds);
}
constexpr int N_PREP_TR = 272 + 64 + 704 + 352 + 96 + 64;

DI void norm_mod_item(int wv, const float* __restrict__ srcLat, const float* __restrict__ srcCtx, const float* __restrict__ nw,
                      const float* __restrict__ mod, int shOff, bf16_t* __restrict__ dst, int item, float* __restrict__ copyCtx = nullptr) {
  const int t512 = otid512(wv);
  const int w = t512 >> 6, lane = t512 & 63;
  const int row = item * 16 + w * 2;
  const float* src = row < NLAT ? srcLat + (size_t)row * 1024 : srcCtx + (size_t)(row - NLAT) * 1024;
  const int v = row < NLAT ? (row >> 13) : 2;
  const float* sh = mod + v * 6144 + shOff;
  const float* sc = sh + 1024;
  float4 x0[4], x1[4], w4[4], s4[4], h4[4];
#pragma unroll
  for (int i = 0; i < 4; ++i) { x0[i] = ((const float4*)src)[lane + 64 * i]; x1[i] = ((const float4*)(src + 1024))[lane + 64 * i]; }
#pragma unroll
  for (int i = 0; i < 4; ++i) { w4[i] = ((const float4*)nw)[lane + 64 * i]; s4[i] = ((const float4*)sc)[lane + 64 * i]; h4[i] = ((const float4*)sh)[lane + 64 * i]; }
  if (copyCtx != nullptr && row >= NLAT) {
#pragma unroll
    for (int i = 0; i < 4; ++i) { ((float4*)(copyCtx + (size_t)(row - NLAT) * 1024))[lane + 64 * i] = x0[i]; ((float4*)(copyCtx + (size_t)(row - NLAT + 1) * 1024))[lane + 64 * i] = x1[i]; }
  }
  float ss0 = 0.f, ss1 = 0.f;
#pragma unroll
  for (int i = 0; i < 4; ++i) {
    ss0 += x0[i].x * x0[i].x + x0[i].y * x0[i].y + x0[i].z * x0[i].z + x0[i].w * x0[i].w;
    ss1 += x1[i].x * x1[i].x + x1[i].y * x1[i].y + x1[i].z * x1[i].z + x1[i].w * x1[i].w;
  }
  ss0 = wave_sum(ss0); ss1 = wave_sum(ss1);
  const float r0 = rsqrtf(ss0 * (1.f / 1024.f) + 1e-6f), r1 = rsqrtf(ss1 * (1.f / 1024.f) + 1e-6f);
#pragma unroll
  for (int i = 0; i < 4; ++i) {
    const int c4 = lane + 64 * i;
    const float m0 = w4[i].x * (1.f + s4[i].x), m1 = w4[i].y * (1.f + s4[i].y), m2 = w4[i].z * (1.f + s4[i].z), m3 = w4[i].w * (1.f + s4[i].w);
    uint2 o;
    o.x = pack2(x0[i].x * r0 * m0 + h4[i].x, x0[i].y * r0 * m1 + h4[i].y);
    o.y = pack2(x0[i].z * r0 * m2 + h4[i].z, x0[i].w * r0 * m3 + h4[i].w);
    *(uint2*)(dst + (size_t)row * 1024 + c4 * 4) = o;
    o.x = pack2(x1[i].x * r1 * m0 + h4[i].x, x1[i].y * r1 * m1 + h4[i].y);
    o.y = pack2(x1[i].z * r1 * m2 + h4[i].z, x1[i].w * r1 * m3 + h4[i].w);
    *(uint2*)(dst + (size_t)(row + 1) * 1024 + c4 * 4) = o;
  }
}

enum { EPI_P0 = 0, EPI_RES = 1, EPI_SWIGLU = 2, EPI_STORE = 3, EPI_QKV = 4 };
struct EpiArgs {
  bf16_t* obf;
  int ldo;
  float* of32;
  float* of32c;
  const float* resLat;
  const float* resCtx;
  const float* gvec;
  const float* bias;
};

typedef float f32x4 __attribute__((ext_vector_type(4)));
constexpr int G_HT = 128 * 64;
DI int lds_byte(int r, int c) {
  int st = (r >> 4) * 2 + (c >> 5), rr = r & 15, cc = c & 31, ob = rr * 64 + cc * 2;
  return st * 1024 + (ob ^ (((ob >> 9) & 1) << 5));
}
DI void stage_rc(int b, int& R, int& C) {
  int st = b / 1024, sb = b % 1024, swz = sb ^ (((sb >> 9) & 1) << 5);
  R = (st >> 1) * 16 + swz / 64; C = (st & 1) * 32 + (swz % 64) / 2;
}

template <int EPI, bool SPLIT>
DI void gemm_phase(int wv, const bf16_t* __restrict__ A, const bf16_t* __restrict__ Bt, int M, int N, int K, const EpiArgs& ea, char* smem, int Mfull = -1, int ksplit = 1) {
  bf16_t* shm = (bf16_t*)smem;
#define SA(b, h) (shm + ((b) * 2 + (h)) * G_HT)
#define SB(b, h) (shm + (4 + (b) * 2 + (h)) * G_HT)
#define STAGE(P, BASE, br, kt) do { const long _g = (long)(br) * K + (long)(kt) * 64 + kofs; \
    _Pragma("unroll") for (int _i = 0; _i < 2; ++_i) { const int _b = tix * 16 + _i * 8192; \
      __builtin_amdgcn_global_load_lds((const unsigned*)((BASE) + _g + (long)srow[_i] * K + scol[_i]), \
        (__attribute__((address_space(3))) unsigned*)((char*)(P) + _b), 16, 0, 0); } } while (0)
#define LDA(dst, b, h) _Pragma("unroll") for (int m = 0; m < 4; ++m) _Pragma("unroll") for (int k = 0; k < 2; ++k) \
    dst[m][k] = *reinterpret_cast<const bf16x8*>((char*)SA(b, h) + lds_byte(wr * 64 + m * 16 + fr, k * 32 + fq * 8))
#define LDB(dst, b, h) _Pragma("unroll") for (int n = 0; n < 2; ++n) _Pragma("unroll") for (int k = 0; k < 2; ++k) \
    dst[n][k] = *reinterpret_cast<const bf16x8*>((char*)SB(b, h) + lds_byte(wc * 32 + n * 16 + fr, k * 32 + fq * 8))
#define MMA(ai, bj, At_, Bt_) do { __builtin_amdgcn_s_setprio(1); \
    _Pragma("unroll") for (int m = 0; m < 4; ++m) _Pragma("unroll") for (int n = 0; n < 2; ++n) _Pragma("unroll") for (int k = 0; k < 2; ++k) \
      acc[ai][bj][m][n] = __builtin_amdgcn_mfma_f32_16x16x32_bf16(Bt_[n][k], At_[m][k], acc[ai][bj][m][n], 0, 0, 0); \
    __builtin_amdgcn_s_setprio(0); } while (0)
#define WAIT_V(n) asm volatile("s_waitcnt vmcnt(" #n ")" ::: "memory")
#define WAIT_L(n) asm volatile("s_waitcnt lgkmcnt(" #n ")" ::: "memory")
#define BAR __builtin_amdgcn_s_barrier()
#define SCHED __builtin_amdgcn_sched_barrier(0)
  if (Mfull < 0) Mfull = M;
  const int nM = Mfull / 256, nN = N / 256, nwg = nM * nN;
  int nunits = nwg;
  if constexpr (SPLIT) nunits += ((M - Mfull) / 256) * nN * ksplit;
  int G = gridDim.x, Lb = blockIdx.x;
  asm volatile("" : "+s"(G), "+s"(Lb));
  for (int L = Lb; L < nunits; L += G) {
    const int tix = otid512(wv);
    const int wid = tix >> 6, lane = tix & 63, wr = wid >> 2, wc = wid & 3, fr = lane & 15, fq = lane >> 4;
    int srow[2], scol[2];
    stage_rc(tix * 16, srow[0], scol[0]);
    stage_rc(tix * 16 + 8192, srow[1], scol[1]);
    int brow, bcol, kofs = 0, nt = K / 64;
    bool split = false;
    if constexpr (SPLIT) split = L >= nwg;
    if (!split) {
      int wgid = L;
      { const int q = nwg / 8, r = nwg % 8, xcd = wgid % 8, off = wgid / 8; wgid = (xcd < r ? xcd * (q + 1) : r * (q + 1) + (xcd - r) * q) + off; }
      const int nig = 8 * nN, gid = wgid / nig, fm = gid * 8, gsz = (nM - fm) < 8 ? (nM - fm) : 8;
      const int pm = fm + ((wgid % nig) % gsz), pn = (wgid % nig) / gsz;
      brow = pm * 256; bcol = pn * 256;
    } else {
      const int u = L - nwg, ks = u % ksplit, tile = u / ksplit;
      brow = Mfull + (tile / nN) * 256; bcol = (tile % nN) * 256;
      nt = nt / ksplit; kofs = ks * nt * 64;
    }
    f32x4 acc[2][2][4][2];
#pragma unroll
    for (int a0 = 0; a0 < 2; ++a0)
#pragma unroll
      for (int a1 = 0; a1 < 2; ++a1)
#pragma unroll
        for (int a2 = 0; a2 < 4; ++a2)
#pragma unroll
          for (int a3 = 0; a3 < 2; ++a3) acc[a0][a1][a2][a3] = f32x4{0.f, 0.f, 0.f, 0.f};
    bf16x8 At[4][2], B0[2][2], B1[2][2];
    STAGE(SB(0, 0), Bt, bcol, 0); STAGE(SA(0, 0), A, brow, 0);
    STAGE(SB(0, 1), Bt, bcol + 128, 0); STAGE(SA(0, 1), A, brow + 128, 0);
    if (wr == 1) BAR;
    WAIT_V(4); BAR;
    STAGE(SB(1, 0), Bt, bcol, 1); STAGE(SA(1, 0), A, brow, 1); STAGE(SB(1, 1), Bt, bcol + 128, 1);
    WAIT_V(6); BAR;
    for (int t = 0; t < nt - 2; t += 2) {
      LDB(B0, 0, 0); SCHED; LDA(At, 0, 0); STAGE(SA(1, 1), A, brow + 128, t + 1);
      WAIT_L(8); BAR; WAIT_L(0); MMA(0, 0, At, B0); BAR; SCHED;
      LDB(B1, 0, 1); STAGE(SB(0, 0), Bt, bcol, t + 2);
      BAR; WAIT_L(0); MMA(0, 1, At, B1); BAR;
      LDA(At, 0, 1); STAGE(SA(0, 0), A, brow, t + 2);
      BAR; WAIT_L(0); MMA(1, 0, At, B0); BAR; SCHED;
      STAGE(SB(0, 1), Bt, bcol + 128, t + 2);
      WAIT_V(6); BAR; MMA(1, 1, At, B1); BAR;
      LDB(B0, 1, 0); SCHED; LDA(At, 1, 0); STAGE(SA(0, 1), A, brow + 128, t + 2);
      WAIT_L(8); BAR; WAIT_L(0); MMA(0, 0, At, B0); BAR; SCHED;
      LDB(B1, 1, 1); STAGE(SB(1, 0), Bt, bcol, t + 3);
      BAR; WAIT_L(0); MMA(0, 1, At, B1); BAR;
      LDA(At, 1, 1); STAGE(SA(1, 0), A, brow, t + 3);
      BAR; WAIT_L(0); MMA(1, 0, At, B0); BAR; SCHED;
      STAGE(SB(1, 1), Bt, bcol + 128, t + 3);
      WAIT_V(6); BAR; MMA(1, 1, At, B1); BAR;
    }
    { LDB(B0, 0, 0); LDA(At, 0, 0); STAGE(SA(1, 1), A, brow + 128, nt - 1);
      BAR; WAIT_L(0); MMA(0, 0, At, B0); BAR;
      LDB(B1, 0, 1); BAR; WAIT_L(0); MMA(0, 1, At, B1); BAR;
      LDA(At, 0, 1); WAIT_V(4); BAR; WAIT_L(0); MMA(1, 0, At, B0); MMA(1, 1, At, B1); BAR; }
    { LDB(B0, 1, 0); LDA(At, 1, 0); WAIT_V(2); BAR; WAIT_L(0); MMA(0, 0, At, B0); BAR;
      LDB(B1, 1, 1); WAIT_V(0); BAR; WAIT_L(0); MMA(0, 1, At, B1); BAR;
      LDA(At, 1, 1); BAR; WAIT_L(0); MMA(1, 0, At, B0); MMA(1, 1, At, B1); BAR; }
    if (wr == 0) BAR;
    float* obase = nullptr; const float* rbase = nullptr; const float* gv = nullptr;
    if (EPI == EPI_RES) {
      const bool isc = brow >= NLAT;
      obase = isc ? ea.of32c - (size_t)NLAT * 1024 : ea.of32;
      rbase = isc ? ea.resCtx - (size_t)NLAT * 1024 : ea.resLat;
      gv = ea.gvec + (isc ? 2 : (brow >> 13)) * 6144;
    }
#pragma unroll
    for (int ai = 0; ai < 2; ++ai)
#pragma unroll
      for (int m = 0; m < 4; ++m) {
        const int row = brow + ai * 128 + wr * 64 + m * 16 + fr;
        if (EPI == EPI_QKV) {
          float x[2][2][4];
#pragma unroll
          for (int bj = 0; bj < 2; ++bj)
#pragma unroll
            for (int n = 0; n < 2; ++n)
#pragma unroll
              for (int j = 0; j < 4; ++j) x[bj][n][j] = acc[ai][bj][m][n][j];
          if (bcol < 1280) {
            float ss = 0.f;
#pragma unroll
            for (int bj = 0; bj < 2; ++bj)
#pragma unroll
              for (int n = 0; n < 2; ++n)
#pragma unroll
                for (int j = 0; j < 4; ++j) ss += x[bj][n][j] * x[bj][n][j];
            ss += swz<16>(ss);
            ss += shfl_lane(ss, lane ^ 32);
            const float rstd = rsqrtf(ss * (1.f / 64.f) + 1e-6f);
            const float* nwp = (bcol < 1024 ? ea.bias : ea.gvec) + fq * 4;
            const float sc_ = bcol < 1024 ? 0.125f * 1.44269504f : 1.f;
            const bool dorope = row < NLAT;
            const float* rr = ea.resLat + (size_t)(row & 8191) * 64 + fq * 4;
#pragma unroll
            for (int n = 0; n < 2; ++n) {
              const float4 w1 = *(const float4*)(nwp + n * 16), w2 = *(const float4*)(nwp + 32 + n * 16);
              float4 c4 = make_float4(1.f, 1.f, 1.f, 1.f), s4 = make_float4(0.f, 0.f, 0.f, 0.f);
              if (dorope) { c4 = *(const float4*)(rr + n * 16); s4 = *(const float4*)(rr + 32 + n * 16); }
              const float wa[4] = {w1.x, w1.y, w1.z, w1.w}, wb[4] = {w2.x, w2.y, w2.z, w2.w}, cc[4] = {c4.x, c4.y, c4.z, c4.w}, sn[4] = {s4.x, s4.y, s4.z, s4.w};
#pragma unroll
              for (int j = 0; j < 4; ++j) {
                const float y1 = x[0][n][j] * rstd * wa[j], y2 = x[1][n][j] * rstd * wb[j];
                x[0][n][j] = (y1 * cc[j] - y2 * sn[j]) * sc_;
                x[1][n][j] = (y2 * cc[j] + y1 * sn[j]) * sc_;
              }
            }
          }
#pragma unroll
          for (int bj = 0; bj < 2; ++bj)
#pragma unroll
            for (int n = 0; n < 2; ++n) {
              uint2 o; o.x = pack2(x[bj][n][0], x[bj][n][1]); o.y = pack2(x[bj][n][2], x[bj][n][3]);
              *(uint2*)&ea.obf[(size_t)row * 1536 + bcol + wc * 64 + bj * 32 + n * 16 + fq * 4] = o;
            }
        } else if (EPI == EPI_SWIGLU) {
#pragma unroll
          for (int n = 0; n < 2; ++n) {
            const f32x4 g = acc[ai][0][m][n], u = acc[ai][1][m][n];
            uint2 o;
            o.x = pack2(siluf_(g[0]) * u[0], siluf_(g[1]) * u[1]);
            o.y = pack2(siluf_(g[2]) * u[2], siluf_(g[3]) * u[3]);
            *(uint2*)&ea.obf[(size_t)row * ea.ldo + (bcol >> 1) + wc * 32 + n * 16 + fq * 4] = o;
          }
        } else {
#pragma unroll
          for (int bj = 0; bj < 2; ++bj)
#pragma unroll
            for (int n = 0; n < 2; ++n) {
              const int col = bcol + bj * 128 + wc * 32 + n * 16 + fq * 4;
              const f32x4 val = acc[ai][bj][m][n];
              if (EPI == EPI_P0) {
                if (bcol < 4096) { uint2 o; o.x = pack2(val[0], val[1]); o.y = pack2(val[2], val[3]); *(uint2*)&ea.obf[(size_t)row * 4096 + col] = o; }
                else if (col < 4128) {
                  const float4 bb = *(const float4*)(ea.bias + (col - 4096));
                  float4 o; o.x = val[0] + bb.x; o.y = val[1] + bb.y; o.z = val[2] + bb.z; o.w = val[3] + bb.w;
                  *(float4*)(ea.of32 + (size_t)row * 32 + (col - 4096)) = o;
                }
              } else if (EPI == EPI_RES) {
                const float4 g = *(const float4*)(gv + col);
                float* op = obase + (size_t)row * 1024 + col;
                bool done = false;
                if constexpr (SPLIT) {
                  if (split) { unsafeAtomicAdd(op, g.x * val[0]); unsafeAtomicAdd(op + 1, g.y * val[1]); unsafeAtomicAdd(op + 2, g.z * val[2]); unsafeAtomicAdd(op + 3, g.w * val[3]); done = true; }
                }
                if (!done) {
                  const float4 rr = *(const float4*)(rbase + (size_t)row * 1024 + col);
                  float4 o; o.x = rr.x + g.x * val[0]; o.y = rr.y + g.y * val[1]; o.z = rr.z + g.z * val[2]; o.w = rr.w + g.w * val[3];
                  *(float4*)op = o;
                }
              } else {
                uint2 o; o.x = pack2(val[0], val[1]); o.y = pack2(val[2], val[3]);
                *(uint2*)&ea.obf[(size_t)row * ea.ldo + col] = o;
              }
            }
        }
      }
    WAIT_V(0);
  }
#undef SA
#undef SB
#undef STAGE
#undef LDA
#undef LDB
#undef MMA
}

DI void chunk_rows(int b, int cc, int& row0, int& pos0, int& slen) {
  if (cc < 2) { row0 = NLAT + b * LC + cc * 128; pos0 = cc * 128; slen = LC; }
  else { row0 = b * SEQ + (cc - 2) * 128; pos0 = (cc - 2) * 128; slen = SEQ; }
}
DI int seq_index(int dir, int cc) { return dir == 0 ? cc : (cc < 2 ? 1 - cc : 67 - cc); }

template <bool WITH_ROW>
DI void mlstm_vecs(const float* __restrict__ gates, int row0, int hd, int dir, int lane, float mprev,
                   float* cv, float* rowv, float* av, float* en, float* tot) {
  const int j0 = 2 * lane, j1 = j0 + 1;
  const int p0 = dir ? 127 - j0 : j0, p1 = dir ? 127 - j1 : j1;
  const float* g0 = gates + (size_t)(row0 + p0) * 32 + dir * 16 + hd;
  const float* g1 = gates + (size_t)(row0 + p1) * 32 + dir * 16 + hd;
  const float i0 = g0[0], f0 = g0[8], i1 = g1[0], f1 = g1[8];
  const float lf0 = logsigf_(f0), lf1 = logsigf_(f1);
  const float s = lf0 + lf1;
  const float incl = wave_scan_sum(s);
  const float excl = incl - s;
  const float b0 = excl + lf0, b1 = b0 + lf1;
  const float c0 = i0 - b0, c1 = i1 - b1;
  const float im = wave_scan_max(fmaxf(c0, c1));
  float em = shfl_lane(im, (lane - 1) & 63);
  if (lane == 0) em = -INFINITY;
  if (WITH_ROW) { cv[p0] = c0; cv[p1] = c1; }
  else { const float mxa = shfl_lane(im, 63); cv[p0] = __expf(c0 - mxa); cv[p1] = __expf(c1 - mxa); }
  if (WITH_ROW) {
    const float pm0 = fmaxf(em, c0), pm1 = im;
    const float al0 = b0 + mprev, al1 = b1 + mprev;
    const float mt0 = fmaxf(al0, b0 + pm0), mt1 = fmaxf(al1, b1 + pm1);
    rowv[p0] = b0 - mt0; rowv[p1] = b1 - mt1;
    av[p0] = __expf(al0 - mt0); av[p1] = __expf(al1 - mt1);
    en[p0] = __expf(-mt0); en[p1] = __expf(-mt1);
  }
  if (lane == 63) { tot[0] = incl; tot[1] = im; }
}

DI void load_qk_l0(KP p, int type, int hd, int is_k, int row, int pos, int slen, bool isLat, int half, float scale, float* v) {
  const bf16_t* P0 = (const bf16_t*)(p->ws + OFF_P0);
  if (type == 0) {
    load32bf(P0 + (size_t)row * 4096 + (is_k ? 512 : 0) + hd * 64 + half * 32, v);
    if (isLat) rope32(v, half, (const float*)(p->ws + OFF_ROPE) + (size_t)pos * 64);
#pragma unroll
    for (int i = 0; i < 32; ++i) v[i] *= scale;
  } else {
    const int ch = (is_k ? 512 : 0) + hd * 64 + half * 32;
    conv_silu32(P0 + (size_t)row * 4096 + 2048 + ch, pos > 0, pos < slen - 1, p->in[13] + ch, p->in[14] + ch, scale, v);
  }
}

DI void unpack8(const uint4 u, float* v) {
  v[0] = __uint_as_float(u.x << 16); v[1] = __uint_as_float(u.x & 0xffff0000u);
  v[2] = __uint_as_float(u.y << 16); v[3] = __uint_as_float(u.y & 0xffff0000u);
  v[4] = __uint_as_float(u.z << 16); v[5] = __uint_as_float(u.z & 0xffff0000u);
  v[6] = __uint_as_float(u.w << 16); v[7] = __uint_as_float(u.w & 0xffff0000u);
}
DI void raw_issue(const bf16_t* rowp, int type, bool hp, bool hn, uint4* a) {
  const uint4 z = make_uint4(0u, 0u, 0u, 0u);
#pragma unroll
  for (int q = 0; q < 4; ++q) a[q] = ((const uint4*)rowp)[q];
#pragma unroll
  for (int q = 0; q < 4; ++q) { a[4 + q] = z; a[8 + q] = z; }
  if (type == 1) {
    if (hp) {
#pragma unroll
      for (int q = 0; q < 4; ++q) a[4 + q] = ((const uint4*)(rowp - 4096))[q];
    }
    if (hn) {
#pragma unroll
      for (int q = 0; q < 4; ++q) a[8 + q] = ((const uint4*)(rowp + 4096))[q];
    }
  }
}
DI void raw_process(KP p, int type, int hd, int is_k, int pos, bool isLat, int half, float scale, const uint4* a, float* v) {
  if (type == 0) {
#pragma unroll
    for (int q = 0; q < 4; ++q) unpack8(a[q], v + q * 8);
    if (isLat) rope32(v, half, (const float*)(p->ws + OFF_ROPE) + (size_t)pos * 64);
#pragma unroll
    for (int i = 0; i < 32; ++i) v[i] *= scale;
  } else {
    const int ch = (is_k ? 512 : 0) + hd * 64 + half * 32;
    const float* cw = p->in[13] + ch; const float* cb = p->in[14] + ch;
#pragma unroll
    for (int q = 0; q < 4; ++q) {
      float x0[8], xm[8], xp[8];
      unpack8(a[q], x0); unpack8(a[4 + q], xm); unpack8(a[8 + q], xp);
#pragma unroll
      for (int g = 0; g < 2; ++g) {
        const float4 b4 = *(const float4*)(cb + q * 8 + g * 4);
        const float4 w0 = *(const float4*)(cw + q * 8 + g * 4);
        const float4 w1 = *(const float4*)(cw + 1024 + q * 8 + g * 4);
        const float4 w2 = *(const float4*)(cw + 2048 + q * 8 + g * 4);
        const float bb[4] = {b4.x, b4.y, b4.z, b4.w}, a0[4] = {w0.x, w0.y, w0.z, w0.w}, a1[4] = {w1.x, w1.y, w1.z, w1.w}, a2[4] = {w2.x, w2.y, w2.z, w2.w};
#pragma unroll
        for (int j = 0; j < 4; ++j) {
          const int e = g * 4 + j;
          const float y = bb[j] + a0[j] * xm[e] + a1[j] * x0[e] + a2[j] * xp[e];
          v[q * 8 + e] = siluf_(y) * scale;
        }
      }
    }
  }
}

DI void phase_kvlocal(int wv, KP p, int item, char* smem) {
  const int tid = otid(wv), lane = tid & 63, w = tid >> 6;
  const int cc = item % NCH, hh = (item / NCH) & 15, b = item / (NCH * 16);
  const int type = hh >> 3, hd = hh & 7;
  int row0, pos0, slen; chunk_rows(b, cc, row0, pos0, slen);
  const bool isLat = cc >= 2;
  bf16_t* sKT = (bf16_t*)smem;
  bf16_t* sVT = sKT + 2 * 64 * LDP;
  float* wgt = (float*)(sVT + 64 * LDP);
  float* tot = wgt + 256;
  const float* gates = (const float*)(p->ws + OFF_GATES);
  if (type == 0) {
    const int dir = tid >> 7, t = tid & 127;
    const float lg = p->in[11][dir * 8 + hd];
    wgt[tid] = dir ? expf(lg * (float)t) : expf(lg * (float)(127 - t));
  } else {
    if (w < 2) mlstm_vecs<false>(gates, row0, hd, w, lane, 0.f, wgt + w * 128, nullptr, nullptr, nullptr, tot + w * 2);
  }
  __syncthreads();
  {
    const int t = tid >> 1, half = tid & 1;
    float kv[32];
    const bf16_t* P0 = (const bf16_t*)(p->ws + OFF_P0);
    const uint4* vp = (const uint4*)(P0 + (size_t)(row0 + t) * 4096 + (type ? 3072 : 1024) + hd * 64 + half * 32);
    const uint4 v0 = vp[0], v1 = vp[1], v2 = vp[2], v3 = vp[3];
    load_qk_l0(p, type, hd, 1, row0 + t, pos0 + t, slen, isLat, half, 0.125f, kv);
    const float w0 = wgt[t], w1 = wgt[128 + t];
#pragma unroll
    for (int i = 0; i < 32; ++i) {
      const int d = half * 32 + i;
      sKT[d * LDP + t] = f2bf(kv[i] * w0);
      sKT[64 * LDP + d * LDP + t] = f2bf(kv[i] * w1);
    }
#define V_SC3(q, vr) do { \
    sVT[(half * 32 + (q) * 8 + 0) * LDP + t] = (bf16_t)((vr).x & 0xffffu); sVT[(half * 32 + (q) * 8 + 1) * LDP + t] = (bf16_t)((vr).x >> 16); \
    sVT[(half * 32 + (q) * 8 + 2) * LDP + t] = (bf16_t)((vr).y & 0xffffu); sVT[(half * 32 + (q) * 8 + 3) * LDP + t] = (bf16_t)((vr).y >> 16); \
    sVT[(half * 32 + (q) * 8 + 4) * LDP + t] = (bf16_t)((vr).z & 0xffffu); sVT[(half * 32 + (q) * 8 + 5) * LDP + t] = (bf16_t)((vr).z >> 16); \
    sVT[(half * 32 + (q) * 8 + 6) * LDP + t] = (bf16_t)((vr).w & 0xffffu); sVT[(half * 32 + (q) * 8 + 7) * LDP + t] = (bf16_t)((vr).w >> 16); } while (0)
    V_SC3(0, v0); V_SC3(1, v1); V_SC3(2, v2); V_SC3(3, v3);
#undef V_SC3
  }
  __syncthreads();
  const int wm = w >> 1, wn = w & 1, r = lane & 31, h = lane >> 5;
  bf16_t* SB = (bf16_t*)(p->ws + OFF_SBUF);
#pragma unroll
  for (int dir = 0; dir < 2; ++dir) {
    f32x16 acc;
#pragma unroll
    for (int i = 0; i < 16; ++i) acc[i] = 0.f;
#pragma unroll
    for (int ks = 0; ks < 8; ++ks) {
      bf16x8 a = *(const bf16x8*)&sKT[dir * 64 * LDP + (wm * 32 + r) * LDP + ks * 16 + h * 8];
      bf16x8 bb = *(const bf16x8*)&sVT[(wn * 32 + r) * LDP + ks * 16 + h * 8];
      acc = MFMA32(a, bb, acc);
    }
    const int sq = ((type * 2 + dir) * 2 + b) * 8 + hd;
    const int si = seq_index(dir, cc);
    bf16_t* dst = SB + ((size_t)sq * NCH + si) * 4096 + (wn * 32 + r) * 64 + wm * 32 + 4 * h;
#pragma unroll
    for (int g = 0; g < 4; ++g) {
      uint2 o; o.x = pack2(acc[4 * g], acc[4 * g + 1]); o.y = pack2(acc[4 * g + 2], acc[4 * g + 3]);
      *(uint2*)(dst + 8 * g) = o;
    }
  }
  if (type == 1 && tid < 128) {
    const int dir = tid >> 6, d = tid & 63;
    const bf16_t* rowp = sKT + dir * 64 * LDP + d * LDP;
    float s = 0.f;
    for (int q = 0; q < 16; ++q) {
      float x[8]; load8bf(rowp + q * 8, x);
#pragma unroll
      for (int j = 0; j < 8; ++j) s += x[j];
    }
    const int sq = ((2 + dir) * 2 + b) * 8 + hd;
    const int si = seq_index(dir, cc);
    ((float*)(p->ws + OFF_NBUF))[((size_t)sq * NCH + si) * 64 + d] = s;
    if (d == 0) {
      float* sc = (float*)(p->ws + OFF_SCAL) + ((size_t)sq * NCH + si) * 2;
      sc[0] = tot[dir * 2] + tot[dir * 2 + 1];
      sc[1] = tot[dir * 2];
    }
  }
  __syncthreads();
}

DI void phase_scan(int wv, KP p, int item) {
  const int tid = otid(wv);
  const int sq = item / 17, blk = item % 17;
  const int type = sq >> 5, dir = (sq >> 4) & 1, hd = sq & 7;
  const float* scal = (const float*)(p->ws + OFF_SCAL) + (size_t)sq * NCH * 2;
  const float adec = type == 0 ? expf(p->in[11][dir * 8 + hd] * 128.f) : 0.f;
  float* mp = (float*)(p->ws + OFF_MPREV) + (size_t)sq * NCH;
  if (blk < 16) {
    bf16_t* ptr = (bf16_t*)(p->ws + OFF_SBUF) + (size_t)sq * NCH * 4096 + blk * 256 + tid;
    float st = 0.f, m = 0.f;
#pragma unroll 1
    for (int n0 = 0; n0 < NCH; n0 += 22) {
      float kv[22];
#pragma unroll
      for (int j = 0; j < 22; ++j) kv[j] = bf2f(ptr[(size_t)(n0 + j) * 4096]);
#pragma unroll
      for (int j = 0; j < 22; ++j) {
        const int n = n0 + j;
        float a, bb;
        if (type == 0) { a = adec; bb = 1.f; }
        else {
          const float gm = scal[n * 2], be = scal[n * 2 + 1];
          const float mn = fmaxf(be + m, gm);
          a = __expf(be + m - mn); bb = __expf(gm - mn);
          m = mn;
        }
        ptr[(size_t)n * 4096] = f2bf(st);
        st = a * st + bb * kv[j];
      }
    }
  } else {
    if (type == 0 || tid > 64) return;
    float* ptr = (float*)(p->ws + OFF_NBUF) + (size_t)sq * NCH * 64 + (tid & 63);
    const bool active = tid < 64, wm = tid == 64;
    float st = 0.f, m = 0.f;
#pragma unroll 1
    for (int n0 = 0; n0 < NCH; n0 += 22) {
      float kv[22];
#pragma unroll
      for (int j = 0; j < 22; ++j) kv[j] = active ? ptr[(size_t)(n0 + j) * 64] : 0.f;
#pragma unroll
      for (int j = 0; j < 22; ++j) {
        const int n = n0 + j;
        const float gm = scal[n * 2], be = scal[n * 2 + 1];
        const float mn = fmaxf(be + m, gm);
        const float a = __expf(be + m - mn), bb = __expf(gm - mn);
        if (wm) mp[n] = m;
        m = mn;
        if (active) ptr[(size_t)n * 64] = st;
        st = a * st + bb * kv[j];
      }
    }
  }
}

DI void phase_chunkout(int wv, KP p, int item, char* smem, bf16_t* __restrict__ MRG) {
  const int tid = otid(wv), lane = tid & 63, w = tid >> 6;
  const int cc = item % NCH, hh = (item / NCH) & 15, b = item / (NCH * 16);
  const int type = hh >> 3, hd = hh & 7;
  int row0, pos0, slen; chunk_rows(b, cc, row0, pos0, slen);
  const bool isLat = cc >= 2;
  bf16_t* sQ = (bf16_t*)smem;
  bf16_t* sK = sQ + 128 * LDT;
  bf16_t* sVT = sK + 128 * LDT;
  bf16_t* sCT = sVT + 64 * LDP;
  float* vec = (float*)(sCT + 2 * 64 * LDT);
  float* rowv = vec;
  float* colv = vec + 256;
  float* av = vec + 512;
  float* en = vec + 768;
  float* qn = vec + 1024;
  float* rsum = vec + 1280;
  float* tot = vec + 1536;
  float* npv = vec + 1540;
  bf16_t* sP = (bf16_t*)smem;
  float* sO = (float*)smem;
  const bf16_t* P0 = (const bf16_t*)(p->ws + OFF_P0);
  const float* gates = (const float*)(p->ws + OFF_GATES);
#define SQD(dir) (((type * 2 + (dir)) * 2 + b) * 8 + hd)
#define SID(dir) seq_index((dir), cc)
  uint4 gr[4];
  {
    const int t = tid >> 1, half = tid & 1;
    const int d = tid >> 2, e0 = (tid & 3) * 16;
    const int pos = pos0 + t;
    const bool hp = pos > 0, hn = pos < slen - 1;
    const bf16_t* rowb = P0 + (size_t)(row0 + t) * 4096 + hd * 64 + half * 32;
    uint4 qr[12], kr[12], vr[4];
    uint4 cx00, cx01, cx10, cx11;
    raw_issue(rowb + (type ? 2048 : 0), type, hp, hn, qr);
    raw_issue(rowb + (type ? 2560 : 512), type, hp, hn, kr);
#pragma unroll
    for (int q = 0; q < 4; ++q) { vr[q] = ((const uint4*)(rowb + (type ? 3072 : 1024)))[q]; }
  if (type == 0) {
    const int dir = tid >> 7, t = tid & 127;
    const float lg = p->in[11][dir * 8 + hd];
    rowv[tid] = dir ? -lg * (float)t : lg * (float)t;
    colv[tid] = dir ? lg * (float)t : -lg * (float)t;
    av[tid] = dir ? expf(lg * (float)(128 - t)) : expf(lg * (float)(t + 1));
  } else {
    if (w < 2) {
      const float mprev = ((const float*)(p->ws + OFF_MPREV))[(size_t)SQD(w) * NCH + SID(w)];
      mlstm_vecs<true>(gates, row0, hd, w, lane, mprev, colv + w * 128, rowv + w * 128, av + w * 128, en + w * 128, tot + w * 2);
    } else if (w == 2) {
      const int dir = lane >> 5;
      const float* nb = (const float*)(p->ws + OFF_NBUF) + ((size_t)SQD(dir) * NCH + SID(dir)) * 64;
      const int d = (lane & 31) * 2;
      npv[dir * 64 + d] = nb[d]; npv[dir * 64 + d + 1] = nb[d + 1];
    }
  }
    __builtin_amdgcn_sched_barrier(0);
    float v[32];
    raw_process(p, type, hd, 0, pos, isLat, half, 1.f, qr, v);
    store32bf(sQ + t * LDT + half * 32, v);
    __builtin_amdgcn_sched_barrier(0);
    {
      const uint4* s0 = (const uint4*)((const bf16_t*)(p->ws + OFF_SBUF) + ((size_t)SQD(0) * NCH + SID(0)) * 4096 + d * 64 + e0);
      const uint4* s1 = (const uint4*)((const bf16_t*)(p->ws + OFF_SBUF) + ((size_t)SQD(1) * NCH + SID(1)) * 4096 + d * 64 + e0);
      cx00 = s0[0]; cx01 = s0[1]; cx10 = s1[0]; cx11 = s1[1];
    }
    __builtin_amdgcn_sched_barrier(0);
    raw_process(p, type, hd, 1, pos, isLat, half, 0.125f, kr, v);
    store32bf(sK + t * LDT + half * 32, v);
    __builtin_amdgcn_sched_barrier(0);
#pragma unroll
    for (int q = 0; q < 4; ++q) {
      const unsigned uu[4] = {vr[q].x, vr[q].y, vr[q].z, vr[q].w};
#pragma unroll
      for (int j = 0; j < 4; ++j) {
        sVT[(half * 32 + q * 8 + 2 * j) * LDV + t] = (bf16_t)(uu[j] & 0xffffu);
        sVT[(half * 32 + q * 8 + 2 * j + 1) * LDV + t] = (bf16_t)(uu[j] >> 16);
      }
    }
    {
      uint4* dp0 = (uint4*)(sCT + d * LDT + e0);
      uint4* dp1 = (uint4*)(sCT + 64 * LDT + d * LDT + e0);
      dp0[0] = cx00; dp0[1] = cx01; dp1[0] = cx10; dp1[1] = cx11;
    }
  }
  __syncthreads();
  const int r = lane & 31, h = lane >> 5;
  bf16x8 qa[4];
#pragma unroll
  for (int ks = 0; ks < 4; ++ks) qa[ks] = *(const bf16x8*)&sQ[(w * 32 + r) * LDT + ks * 16 + h * 8];
  f32x16 accS[4];
#pragma unroll
  for (int tn = 0; tn < 4; ++tn) {
#pragma unroll
    for (int i = 0; i < 16; ++i) accS[tn][i] = 0.f;
#pragma unroll
    for (int ks = 0; ks < 4; ++ks) {
      bf16x8 kk = *(const bf16x8*)&sK[(tn * 32 + r) * LDT + ks * 16 + h * 8];
      accS[tn] = MFMA32(kk, qa[ks], accS[tn]);
    }
  }
  if (type == 1) {
    const int dir = tid >> 7, t = tid & 127;
    float s = 0.f;
    for (int q = 0; q < 8; ++q) {
      float x[8]; load8bf(sQ + t * LDT + q * 8, x);
#pragma unroll
      for (int j = 0; j < 8; ++j) s += x[j] * npv[dir * 64 + q * 8 + j];
    }
    qn[tid] = s;
  }
  __syncthreads();
  f32x16 accSum[2];
#pragma unroll
  for (int i = 0; i < 16; ++i) { accSum[0][i] = 0.f; accSum[1][i] = 0.f; }
  const int ws = wv & 3;
  const int tq = w * 32 + r;
#pragma unroll 1
  for (int dir = 0; dir < 2; ++dir) {
    const float* cvp = colv + dir * 128;
    const bf16_t* ct = sCT + dir * 64 * LDT;
    const float rvt = rowv[dir * 128 + tq];
    const float at = av[dir * 128 + tq];
    f32x16 accD[2];
#pragma unroll
    for (int i = 0; i < 16; ++i) { accD[0][i] = 0.f; accD[1][i] = 0.f; }
#pragma unroll
    for (int ks = 0; ks < 4; ++ks) {
      bf16x8 c0 = *(const bf16x8*)&ct[r * LDT + ks * 16 + h * 8];
      bf16x8 c1 = *(const bf16x8*)&ct[(32 + r) * LDT + ks * 16 + h * 8];
      accD[0] = MFMA32(c0, qa[ks], accD[0]);
      accD[1] = MFMA32(c1, qa[ks], accD[1]);
    }
#pragma unroll
    for (int i = 0; i < 16; ++i) { accD[0][i] *= at; accD[1][i] *= at; }
    float lsum = 0.f;
    int tl = tq; asm volatile("" : "+v"(tl));
#pragma unroll
    for (int tn = 0; tn < 4; ++tn) {
      const bool dead = dir ? (tn < ws) : (tn > ws);
      if (dead) continue;
      float pe[16];
      if (tn == ws) {
#pragma unroll
        for (int i = 0; i < 16; ++i) {
          const int s = tn * 32 + crow(i, h);
          const bool ok = dir ? (s >= tl) : (s <= tl);
          pe[i] = ok ? accS[tn][i] * __expf(rvt + cvp[s]) : 0.f;
        }
      } else {
#pragma unroll
        for (int i = 0; i < 16; ++i) pe[i] = accS[tn][i] * __expf(rvt + cvp[tn * 32 + crow(i, h)]);
      }
#pragma unroll
      for (int i = 0; i < 16; ++i) lsum += pe[i];
#pragma unroll
      for (int st = 0; st < 2; ++st) {
        uint4 pk;
        pk.x = pack2(pe[8 * st + 0], pe[8 * st + 1]); pk.y = pack2(pe[8 * st + 2], pe[8 * st + 3]);
        pk.z = pack2(pe[8 * st + 4], pe[8 * st + 5]); pk.w = pack2(pe[8 * st + 6], pe[8 * st + 7]);
        const bf16x8 pb = __builtin_bit_cast(bf16x8, pk);
#pragma unroll
        for (int et = 0; et < 2; ++et) {
          const bf16_t* vp = sVT + (et * 32 + r) * LDV + tn * 32 + 16 * st + 4 * h;
          const s16x4 lo = *(const s16x4*)vp, hi = *(const s16x4*)(vp + 8);
          const bf16x8 va = __builtin_shufflevector(lo, hi, 0, 1, 2, 3, 4, 5, 6, 7);
          accD[et] = MFMA32(va, pb, accD[et]);
        }
      }
      __builtin_amdgcn_sched_barrier(0);
    }
    float inv = 1.f;
    if (type == 1) {
      const float rs = lsum + shfl_lane(lsum, lane ^ 32);
      const float d0 = rs + at * qn[dir * 128 + tq];
      inv = __builtin_amdgcn_rcpf(fmaxf(fabsf(d0), en[dir * 128 + tq]));
    }
#pragma unroll
    for (int i = 0; i < 16; ++i) { accSum[0][i] += accD[0][i] * inv; accSum[1][i] += accD[1][i] * inv; }
  }
  {
    const int tg = otid(wv);
    const uint4* gp = (const uint4*)(P0 + (size_t)(row0 + (tg >> 1)) * 4096 + (type ? 3584 : 1536) + hd * 64 + (tg & 1) * 32);
#pragma unroll
    for (int q = 0; q < 4; ++q) gr[q] = gp[q];
  }
#pragma unroll
  for (int i = 0; i < 16; ++i) {
    sO[tq * 65 + crow(i, h)] = accSum[0][i];
    sO[tq * 65 + 32 + crow(i, h)] = accSum[1][i];
  }
  __syncthreads();
  {
    const int t = tid >> 1, half = tid & 1;
    float o[32], g[32];
    float ss = 0.f;
#pragma unroll
    for (int i = 0; i < 32; ++i) { o[i] = sO[t * 65 + half * 32 + i]; ss += o[i] * o[i]; }
    ss += shx<1>(ss);
    const float rstd = rsqrtf(ss * (1.f / 64.f) + 1e-6f);
#pragma unroll
    for (int q = 0; q < 4; ++q) unpack8(gr[q], g + q * 8);
    const float* nw = (type ? p->in[16] : p->in[12]) + hd * 64 + half * 32;
#pragma unroll
    for (int i = 0; i < 32; ++i) {
      const float gt = type ? sigmoidf_(g[i]) : siluf_(g[i]);
      o[i] = o[i] * rstd * nw[i] * gt;
    }
    store32bf(MRG + (size_t)(row0 + t) * 1024 + type * 512 + hd * 64 + half * 32, o);
  }
  __syncthreads();
}

DI void load_qk_l1(const bf16_t* __restrict__ src, const float* __restrict__ nw, const float* __restrict__ ropeRow, bool doRope, int half, float scale, float* v) {
  load32bf(src, v);
  float ss = 0.f;
#pragma unroll
  for (int i = 0; i < 32; ++i) ss += v[i] * v[i];
  ss += shx<1>(ss);
  const float rstd = rsqrtf(ss * (1.f / 64.f) + 1e-6f);
#pragma unroll
  for (int q = 0; q < 8; ++q) {
    const float4 w4 = *(const float4*)(nw + half * 32 + q * 4);
    v[q * 4 + 0] *= rstd * w4.x; v[q * 4 + 1] *= rstd * w4.y; v[q * 4 + 2] *= rstd * w4.z; v[q * 4 + 3] *= rstd * w4.w;
  }
  if (doRope) rope32(v, half, ropeRow);
#pragma unroll
  for (int i = 0; i < 32; ++i) v[i] *= scale;
}


DI void phase_attn(int wv, KP p, int item, char* smem) {
  const int tid = otid(wv), lane = tid & 63, w = tid >> 6, r = lane & 31, h = lane >> 5;
  const int qb = item & 63, hq = (item >> 6) & 15, b = item >> 10;
  const int hkv = hq >> 2;
  constexpr int BUF_ELEMS = 128 * LDT + 64 * LDV;
  bf16_t* sbase = (bf16_t*)smem;
  const bf16_t* QKV = (const bf16_t*)(p->ws + OFF_QKV);
  const int t2 = tid >> 1, half = tid & 1;
  uint4 kr0 = make_uint4(0, 0, 0, 0), kr1 = kr0, kr2 = kr0, kr3 = kr0, vr0 = kr0, vr1 = kr0, vr2 = kr0, vr3 = kr0;
#define TILE_VALID(kt) ((kt) >= 3 || (qb - 1 + (kt) >= 0 && qb - 1 + (kt) < 64))
#define TILE_ROW0(kt) ((kt) < 3 ? b * SEQ + (qb - 1 + (kt)) * 128 : NLAT + b * LC + ((kt) - 3) * 128)
#define TILE_LOAD(kt) do { const uint4* kp_ = (const uint4*)(QKV + (size_t)(TILE_ROW0(kt) + t2) * 1536 + 1024 + hkv * 64 + half * 32); \
    kr0 = kp_[0]; kr1 = kp_[1]; kr2 = kp_[2]; kr3 = kp_[3]; vr0 = kp_[32]; vr1 = kp_[33]; vr2 = kp_[34]; vr3 = kp_[35]; } while (0)
#define V_SCATTER(q, vr) do { \
    sVT[(half * 32 + (q) * 8 + 0) * LDV + t2] = (bf16_t)((vr).x & 0xffffu); sVT[(half * 32 + (q) * 8 + 1) * LDV + t2] = (bf16_t)((vr).x >> 16); \
    sVT[(half * 32 + (q) * 8 + 2) * LDV + t2] = (bf16_t)((vr).y & 0xffffu); sVT[(half * 32 + (q) * 8 + 3) * LDV + t2] = (bf16_t)((vr).y >> 16); \
    sVT[(half * 32 + (q) * 8 + 4) * LDV + t2] = (bf16_t)((vr).z & 0xffffu); sVT[(half * 32 + (q) * 8 + 5) * LDV + t2] = (bf16_t)((vr).z >> 16); \
    sVT[(half * 32 + (q) * 8 + 6) * LDV + t2] = (bf16_t)((vr).w & 0xffffu); sVT[(half * 32 + (q) * 8 + 7) * LDV + t2] = (bf16_t)((vr).w >> 16); } while (0)
  if (TILE_VALID(0)) TILE_LOAD(0);
  bf16x8 qa[4];
  {
    const bf16_t* qp = QKV + (size_t)(b * SEQ + qb * 128 + w * 32 + r) * 1536 + hq * 64 + h * 8;
#pragma unroll
    for (int ks = 0; ks < 4; ++ks) qa[ks] = *(const bf16x8*)(qp + ks * 16);
  }
  float wqm = 0.f, wkm = 0.f;
  {
    const float a_ = fabsf(p->in[19][lane]), b_ = fabsf(p->in[20][lane]);
    wqm = row16_max(a_); wqm = fmaxf(wqm, swz<16>(wqm)); wqm = fmaxf(wqm, shfl_lane(wqm, lane ^ 32));
    wkm = row16_max(b_); wkm = fmaxf(wkm, swz<16>(wkm)); wkm = fmaxf(wkm, shfl_lane(wkm, lane ^ 32));
  }
  const float snk2 = p->in[21][hq] * 1.44269504f;
  const float cshift = fmaxf(8.f * 1.44269504f * wqm * wkm, snk2);
  float lsum;
  f32x16 accO[2];
  float zero_ = 0.f, ninit = -cshift;
  asm volatile("" : "+v"(zero_), "+v"(ninit));
  lsum = zero_;
#pragma unroll
  for (int i = 0; i < 16; ++i) { accO[0][i] = zero_; accO[1][i] = zero_; }
#pragma unroll 1
  for (int kt = 0; kt < 5; ++kt) {
    const bool valid = TILE_VALID(kt);
    bf16_t* sK = sbase + (kt & 1) * BUF_ELEMS;
    bf16_t* sVT = sK + 128 * LDT;
    if (valid) {
      uint4* kd = (uint4*)(sK + t2 * LDT + half * 32);
      kd[0] = kr0; kd[1] = kr1; kd[2] = kr2; kd[3] = kr3;
      V_SCATTER(0, vr0); V_SCATTER(1, vr1); V_SCATTER(2, vr2); V_SCATTER(3, vr3);
    }
    __syncthreads();
    if (kt + 1 < 5 && TILE_VALID(kt + 1)) TILE_LOAD(kt + 1);
    if (valid) {
      const bool edge = (kt == 0 || kt == 2);
      const int ws = wv & 3;
      int tl = w * 32 + r; asm volatile("" : "+v"(tl));
#pragma unroll 1
      for (int tn = 0; tn < 4; ++tn) {
        if ((kt == 0 && tn < ws) || (kt == 2 && tn > ws)) continue;
        const bool diag = edge && tn == ws;
        f32x16 acc;
#pragma unroll
        for (int i = 0; i < 16; ++i) acc[i] = ninit;
#pragma unroll
        for (int ks = 0; ks < 4; ++ks) {
          bf16x8 kk = *(const bf16x8*)&sK[(tn * 32 + r) * LDT + ks * 16 + h * 8];
          acc = MFMA32(kk, qa[ks], acc);
        }
        float pe[16];
        if (diag) {
#pragma unroll
          for (int i = 0; i < 16; ++i) {
            const int sl = tn * 32 + crow(i, h);
            const bool ok = (kt == 0) ? (sl >= tl) : (sl <= tl);
            pe[i] = ok ? __builtin_amdgcn_exp2f(acc[i]) : 0.f;
          }
        } else {
#pragma unroll
          for (int i = 0; i < 16; ++i) pe[i] = __builtin_amdgcn_exp2f(acc[i]);
        }
        float s8 = 0.f;
#pragma unroll
        for (int i = 0; i < 16; ++i) s8 += pe[i];
        lsum += s8;
#pragma unroll
        for (int st = 0; st < 2; ++st) {
          uint4 pk;
          pk.x = pack2(pe[8 * st + 0], pe[8 * st + 1]); pk.y = pack2(pe[8 * st + 2], pe[8 * st + 3]);
          pk.z = pack2(pe[8 * st + 4], pe[8 * st + 5]); pk.w = pack2(pe[8 * st + 6], pe[8 * st + 7]);
          const bf16x8 pb = __builtin_bit_cast(bf16x8, pk);
#pragma unroll
          for (int et = 0; et < 2; ++et) {
            const bf16_t* vp = sVT + (et * 32 + r) * LDV + tn * 32 + 16 * st + 4 * h;
            const s16x4 lo = *(const s16x4*)vp, hi = *(const s16x4*)(vp + 8);
            const bf16x8 va = __builtin_shufflevector(lo, hi, 0, 1, 2, 3, 4, 5, 6, 7);
            accO[et] = MFMA32(va, pb, accO[et]);
          }
        }
      }
    }
  }
  __syncthreads();
#undef TILE_VALID
#undef TILE_ROW0
#undef TILE_LOAD
#undef V_SCATTER
  const float ltot = lsum + shfl_lane(lsum, lane ^ 32);
  const float inv = 1.f / (ltot + __builtin_amdgcn_exp2f(snk2 - cshift));
  bf16_t* dst = (bf16_t*)(p->ws + OFF_AO) + (size_t)(b * SEQ + qb * 128 + w * 32 + r) * 1024 + hq * 64 + 4 * h;
#pragma unroll
  for (int et = 0; et < 2; ++et)
#pragma unroll
    for (int g = 0; g < 4; ++g) {
      uint2 o;
      o.x = pack2(accO[et][4 * g] * inv, accO[et][4 * g + 1] * inv);
      o.y = pack2(accO[et][4 * g + 2] * inv, accO[et][4 * g + 3] * inv);
      *(uint2*)(dst + et * 32 + 8 * g) = o;
    }
}

#define XB_TMO      128
#define XB_XCNT(j)  (256  + 64 * (j))
#define XB_XSUB(j)  (1280 + 64 * (j))
#define XB_XGEN(j)  (2304 + 64 * (j))
#define XB_TOP      3328
#define XB_TOPGEN   3392
#define XCD_BAR_WORDS 3456
#define XB_SPIN_CAP (1u << 18)
DI unsigned xb_ld(unsigned* p) { return __hip_atomic_load(p, __ATOMIC_RELAXED, __HIP_MEMORY_SCOPE_AGENT); }
DI unsigned xb_add(unsigned* p, unsigned v) { return __hip_atomic_fetch_add(p, v, __ATOMIC_RELAXED, __HIP_MEMORY_SCOPE_AGENT); }
DI unsigned xb_xcc_id() { return (unsigned)__builtin_amdgcn_s_getreg((3 << 11) | 20) & 0xFu; }
#define XB_SPIN(cond, bar) do { unsigned _sp = 0; while (cond) { __builtin_amdgcn_s_sleep(1); \
    if ((++_sp & 255u) == 0u) { if (xb_ld(&(bar)[XB_TMO])) break; if (_sp > XB_SPIN_CAP) { atomicAdd(&(bar)[XB_TMO], 1u); break; } } } } while (0)
DI void xcd_barrier_complete(unsigned* bar, unsigned x, unsigned& nloc, unsigned& nx) {
  const unsigned G = gridDim.x;
  unsigned sum, cnt, mine, sp = 0u;
  for (;;) {
    sum = 0u; cnt = 0u; mine = 0u;
#pragma unroll
    for (unsigned j = 0; j < 16; ++j) { const unsigned c = xb_ld(&bar[XB_XCNT(j)]); sum += c; cnt += (c > 0u) ? 1u : 0u; mine = (j == x) ? c : mine; }
    if (sum == G) break;
    __builtin_amdgcn_s_sleep(1);
    if ((++sp & 255u) == 0u) { if (xb_ld(&bar[XB_TMO])) break; if (sp > XB_SPIN_CAP) { atomicAdd(&bar[XB_TMO], 1u); break; } }
  }
  nloc = mine > 0u ? mine : 1u; nx = cnt > 0u ? cnt : 1u;
}
DI void xcd_barrier(int wv, unsigned* bar, volatile unsigned* st) {
  asm volatile("s_waitcnt vmcnt(0)" ::: "memory");
  __syncthreads();
  if (wv == 0 && lane_id() == 0) {
    const unsigned x = xb_xcc_id();
    __builtin_amdgcn_s_waitcnt(0);
    unsigned nloc = st[0], nx = st[1];
    if (nloc == 0u) { xcd_barrier_complete(bar, x, nloc, nx); st[0] = nloc; st[1] = nx; }
    const unsigned old = xb_add(&bar[XB_XSUB(x)], 1u);
    const unsigned gen = old / nloc;
    if (old + 1u == (gen + 1u) * nloc) {
      __builtin_amdgcn_fence(__ATOMIC_RELEASE, "agent");
      asm volatile("s_waitcnt vmcnt(0)" ::: "memory");
      const unsigned og = xb_add(&bar[XB_TOP], 1u);
      const unsigned tg = og / nx;
      if (og + 1u == (tg + 1u) * nx) xb_add(&bar[XB_TOPGEN], 1u);
      else XB_SPIN(xb_ld(&bar[XB_TOPGEN]) == tg, bar);
      __builtin_amdgcn_fence(__ATOMIC_ACQUIRE, "agent");
      xb_add(&bar[XB_XGEN(x)], 1u);
      asm volatile("s_waitcnt vmcnt(0)" ::: "memory");
    } else {
      XB_SPIN(xb_ld(&bar[XB_XGEN(x)]) == gen, bar);
      __builtin_amdgcn_fence(__ATOMIC_ACQUIRE, "agent");
      asm volatile("s_waitcnt vmcnt(0)" ::: "memory");
    }
  }
  __syncthreads();
}

constexpr int N_PHASES = 17;

#define PAIR_LOOP(NITEMS, CALL) for (int pr = B0; pr < (NITEMS) / 2; pr += G) { const int it = 2 * pr + hb; CALL; }

DI void run_phase(int wv, KP p, int ph, char* smem) {
  asm volatile("" : "+s"(p));
  int G = gridDim.x, B0 = blockIdx.x;
  asm volatile("" : "+s"(G), "+s"(B0));
  const int hb = wv >> 2;
  char* sm = smem + hb * HALF_SMEM;
  const float* mod0 = (const float*)(p->ws + OFF_MOD);
  const float* mod1 = mod0 + 3 * 6144;
  bf16_t* HB = (bf16_t*)p->out;
  float* X = (float*)(p->ws + OFF_X);
  float* XC = (float*)(p->ws + OFF_XC);
  bf16_t* ACT = (bf16_t*)(p->ws + OFF_ACT);
  EpiArgs ea{};
  switch (ph) {
    case 0:
      PAIR_LOOP(N_PREP_TR, phase_prep_tr(wv, p, it, sm));
      for (int pr = G - 1 - B0; pr < 384 / 2; pr += G) { const int it = 2 * pr + hb; prep_mod(wv, p, it, (float*)sm); }
      for (int pr = G - 1 - B0 - 192; pr >= 0 && pr < 64 / 2; pr += G) { const int it = 2 * pr + hb; prep_rope(wv, p, it); }
      break;
    case 1:
      for (int it = B0; it < MROWS / 16; it += G) norm_mod_item(wv, p->in[0], p->in[2], p->in[6], mod0, 0, HB, it, XC);
      break;
    case 2:
      ea.obf = (bf16_t*)(p->ws + OFF_P0); ea.of32 = (float*)(p->ws + OFF_GATES); ea.bias = p->in[15];
      gemm_phase<EPI_P0, false>(wv, HB, (const bf16_t*)(p->ws + OFF_WIN0), MROWS, 4352, 1024, ea, smem);
      break;
    case 3:
      PAIR_LOOP(2 * 16 * NCH, phase_kvlocal(wv, p, it, sm));
      break;
    case 4:
      PAIR_LOOP(64 * 17, phase_scan(wv, p, it));
      break;
    case 5:
      PAIR_LOOP(2 * 16 * NCH, phase_chunkout(wv, p, it, sm, HB));
      break;
    case 6:
      ea.of32 = X; ea.of32c = XC; ea.resLat = p->in[0]; ea.resCtx = p->in[2]; ea.gvec = mod0 + 2048;
      gemm_phase<EPI_RES, true>(wv, HB, (const bf16_t*)(p->ws + OFF_WOUT0), MROWS, 1024, 1024, ea, smem, NLAT, 4);
      break;
    case 7:
      for (int it = B0; it < MROWS / 16; it += G) norm_mod_item(wv, X, XC, p->in[6] + 1024, mod0, 3072, HB, it);
      break;
    case 8:
      ea.obf = ACT; ea.ldo = DFF;
      gemm_phase<EPI_SWIGLU, false>(wv, HB, (const bf16_t*)(p->ws + OFF_WFI), MROWS, 5632, 1024, ea, smem);
      break;
    case 9:
      ea.of32 = X; ea.of32c = XC; ea.resLat = X; ea.resCtx = XC; ea.gvec = mod0 + 5120;
      gemm_phase<EPI_RES, true>(wv, ACT, (const bf16_t*)(p->ws + OFF_WFO), MROWS, 1024, DFF, ea, smem, NLAT, 11);
      break;
    case 10:
      for (int it = B0; it < MROWS / 16; it += G) norm_mod_item(wv, X, XC, p->in[6] + 2048, mod1, 0, HB, it);
      break;
    case 11:
      ea.obf = (bf16_t*)(p->ws + OFF_QKV); ea.ldo = 1536; ea.bias = p->in[19]; ea.gvec = p->in[20]; ea.resLat = (const float*)(p->ws + OFF_ROPE);
      gemm_phase<EPI_QKV, false>(wv, HB, (const bf16_t*)(p->ws + OFF_WAI), MROWS, 1536, 1024, ea, smem);
      break;
    case 12:
      PAIR_LOOP(2048, phase_attn(wv, p, it, sm));
      break;
    case 13:
      ea.of32 = X; ea.resLat = X; ea.resCtx = X; ea.gvec = mod1 + 2048;
      gemm_phase<EPI_RES, false>(wv, (const bf16_t*)(p->ws + OFF_AO), (const bf16_t*)(p->ws + OFF_WAO), NLAT, 1024, 1024, ea, smem);
      break;
    case 14:
      for (int it = B0; it < NLAT / 16; it += G) norm_mod_item(wv, X, X, p->in[6] + 3072, mod1, 3072, HB, it);
      break;
    case 15:
      ea.obf = ACT; ea.ldo = DFF;
      gemm_phase<EPI_SWIGLU, false>(wv, HB, (const bf16_t*)(p->ws + OFF_WFI) + (size_t)5632 * 1024, NLAT, 5632, 1024, ea, smem);
      break;
    case 16:
      ea.of32 = p->out; ea.resLat = X; ea.resCtx = X; ea.gvec = mod1 + 5120;
      gemm_phase<EPI_RES, false>(wv, ACT, (const bf16_t*)(p->ws + OFF_WFO) + (size_t)1024 * DFF, NLAT, 1024, DFF, ea, smem);
      break;
    default: break;
  }
}

#ifndef CG_SYNCS
#define CG_SYNCS 0
#endif
__global__ void __launch_bounds__(NTHR, 2) mega_fwd(Params pargs, int ph_lo, int ph_hi) {
  extern __shared__ __attribute__((aligned(16))) char smem[];
  KP p = (KP)__builtin_amdgcn_kernarg_segment_ptr();
  const int wv = __builtin_amdgcn_readfirstlane((int)(threadIdx.x >> 6));
  volatile unsigned* st = (volatile unsigned*)(smem + SMEM_BYTES);
  {
    unsigned* bar = (unsigned*)(p->ws + OFF_BAR);
    if (wv == 0 && lane_id() == 0) { st[0] = 0u; st[1] = 0u; (void)xb_add(&bar[XB_XCNT(xb_xcc_id())], 1u); }
    __syncthreads();
  }
  if (ph_hi < 0) cg::this_grid().sync();
  for (int ph = ph_lo; ph < ph_hi; ++ph) {
    run_phase(wv, p, ph, smem);
#if REPEAT_MASK
    if ((REPEAT_MASK >> ph) & 1) { xcd_barrier(wv, (unsigned*)(p->ws + OFF_BAR), st); run_phase(wv, p, ph, smem); }
#endif
    if (ph + 1 < ph_hi) {
      if (ph - ph_lo < CG_SYNCS) cg::this_grid().sync();
      else xcd_barrier(wv, (unsigned*)(p->ws + OFF_BAR), st);
    }
#if EXTRA_SYNCS
    if (ph == 0) { for (int e = 0; e < EXTRA_SYNCS; ++e) xcd_barrier(wv, (unsigned*)(p->ws + OFF_BAR), st); }
#endif
  }
}

extern "C" void kernel_launch(void* const* d_in, const int* in_sizes, int n_in, void* d_out, int out_size, void* d_ws, size_t ws_size, hipStream_t stream) {
  static int grid_blocks = 0;
  if (grid_blocks == 0) {
    if (n_in != 22 || out_size != NLAT * DM || ws_size < WS_END)
      fprintf(stderr, "kernel_launch: unexpected shapes n_in %d out %d ws %zu (need %zu)\n", n_in, out_size, ws_size, (size_t)WS_END);
    int dev = 0, cus = 0, per_cu = 0;
    (void)hipGetDevice(&dev);
    (void)hipDeviceGetAttribute(&cus, hipDeviceAttributeMultiprocessorCount, dev);
    (void)hipFuncSetAttribute((const void*)mega_fwd, hipFuncAttributeMaxDynamicSharedMemorySize, LDS_TOTAL);
    (void)hipOccupancyMaxActiveBlocksPerMultiprocessor(&per_cu, (const void*)mega_fwd, NTHR, LDS_TOTAL);
    if (per_cu < 1) fprintf(stderr, "kernel_launch: occupancy query reports %d blocks per CU\n", per_cu);
    grid_blocks = cus;
    fprintf(stderr, "kernel_launch: cus %d per_cu %d grid %d\n", cus, per_cu, grid_blocks);
  }
  Params p{};
  for (int i = 0; i < 22; ++i) p.in[i] = (const float*)d_in[i];
  p.out = (float*)d_out;
  p.ws = (char*)d_ws;
  (void)hipMemsetAsync((char*)d_ws + OFF_BAR, 0, 16384, stream);
#if MULTI_LAUNCH
  for (int ph = 0; ph < N_PHASES; ++ph) {
    int lo = ph, hi = ph + 1;
    hipLaunchKernelGGL(mega_fwd, dim3(grid_blocks), dim3(NTHR), LDS_TOTAL, stream, p, lo, hi);
  }
#else
  int lo = 0, hi = N_PHASES;
  void* args[] = {&p, &lo, &hi};
  hipError_t e = hipLaunchCooperativeKernel((const void*)mega_fwd, dim3(grid_blocks), dim3(NTHR), args, LDS_TOTAL, stream);
  if (e != hipSuccess) fprintf(stderr, "cooperative launch failed: %s (grid %d)\n", hipGetErrorString(e), grid_blocks);
#endif
}
```

```cpp
#include <hip/hip_runtime.h>
#include <hip/hip_cooperative_groups.h>
#include <cstdio>
#include <cstdint>
namespace cg = cooperative_groups;

#ifndef REPEAT_MASK
#define REPEAT_MASK 0
#endif
#ifndef EXTRA_SYNCS
#define EXTRA_SYNCS 0
#endif
#ifndef MULTI_LAUNCH
#define MULTI_LAUNCH 0
#endif

typedef unsigned short bf16_t;
typedef short bf16x8 __attribute__((ext_vector_type(8)));
typedef float f32x16 __attribute__((ext_vector_type(16)));
#define DI __device__ __forceinline__
#define MFMA32(a, b, c) __builtin_amdgcn_mfma_f32_32x32x16_bf16((a), (b), (c), 0, 0, 0)

constexpr int SEQ = 8192, LC = 256, DM = 1024;
constexpr int NLAT = 2 * SEQ;
constexpr int MROWS = NLAT + 2 * LC;
constexpr int DFF = 2816;
constexpr int NCH = 66;
constexpr int LDT = 72;
constexpr int LDP = 136;
constexpr int LDV = 132;
typedef short s16x4 __attribute__((ext_vector_type(4)));
constexpr int HALF_SMEM = 80896;
constexpr int SMEM_BYTES = 2 * HALF_SMEM;
constexpr int NTHR = 512;
constexpr int LDS_TOTAL = SMEM_BYTES + 16;

constexpr size_t OFF_WIN0 = 0;
constexpr size_t OFF_WOUT0 = OFF_WIN0 + 4352ull * 1024 * 2;
constexpr size_t OFF_WFI = OFF_WOUT0 + 1024ull * 1024 * 2;
constexpr size_t OFF_WFO = OFF_WFI + 2ull * 5632 * 1024 * 2;
constexpr size_t OFF_WAI = OFF_WFO + 2ull * 1024 * 2816 * 2;
constexpr size_t OFF_WAO = OFF_WAI + 1536ull * 1024 * 2;
constexpr size_t OFF_MOD = OFF_WAO + 1024ull * 1024 * 2;
constexpr size_t OFF_ROPE = OFF_MOD + 2ull * 3 * 6144 * 4;
constexpr size_t OFF_NBUF = OFF_ROPE + 8192ull * 64 * 4;
constexpr size_t OFF_SCAL = OFF_NBUF + 64ull * 66 * 64 * 4;
constexpr size_t OFF_MPREV = OFF_SCAL + 64ull * 66 * 2 * 4;
constexpr size_t OFF_ARENA = (OFF_MPREV + 64ull * 66 * 4 + 255) & ~255ull;
constexpr size_t OFF_P0 = OFF_ARENA;
constexpr size_t OFF_GATES = OFF_P0 + (size_t)MROWS * 4096 * 2;
constexpr size_t OFF_SBUF = OFF_GATES + (size_t)MROWS * 32 * 4;
constexpr size_t OFF_X = OFF_ARENA;
constexpr size_t OFF_ACT = OFF_X + (size_t)MROWS * 1024 * 4;
constexpr size_t OFF_QKV = OFF_ACT;
constexpr size_t OFF_AO = OFF_QKV + (size_t)MROWS * 1536 * 2;
constexpr size_t OFF_BAR = (OFF_SBUF + 64ull * 66 * 4096 * 2 + 255) & ~255ull;
constexpr size_t OFF_XC = OFF_BAR + 16384;
constexpr size_t WS_END = OFF_XC + 512ull * 1024 * 4;

struct Params {
  const float* in[22];
  float* out;
  char* ws;
};
typedef const __attribute__((address_space(4))) Params* KP;

typedef float f32x2_t __attribute__((ext_vector_type(2)));
typedef __bf16 bf16x2_t __attribute__((ext_vector_type(2)));
DI unsigned pack2(float a, float b) { f32x2_t v = {a, b}; bf16x2_t r = __builtin_convertvector(v, bf16x2_t); return __builtin_bit_cast(unsigned, r); }
DI bf16_t f2bf(float x) { return (bf16_t)(pack2(x, x) & 0xffffu); }
DI float bf2f(bf16_t v) { return __uint_as_float(((unsigned)v) << 16); }
DI float sigmoidf_(float x) { return __builtin_amdgcn_rcpf(1.f + __expf(-x)); }
DI float siluf_(float x) { return x * __builtin_amdgcn_rcpf(1.f + __expf(-x)); }
DI float logsigf_(float x) { return fminf(x, 0.f) - __logf(1.f + __expf(-fabsf(x))); }
DI int lane_id() { int l; asm volatile("v_mbcnt_lo_u32_b32 %0, -1, 0\n\tv_mbcnt_hi_u32_b32 %0, -1, %0" : "=v"(l)); return l; }
template <int O> DI float swz(float v) { return __int_as_float(__builtin_amdgcn_ds_swizzle(__float_as_int(v), 0x1f | (O << 10))); }
template <int CTRL> DI float dpp(float v) { return __int_as_float(__builtin_amdgcn_update_dpp(0, __float_as_int(v), CTRL, 0xf, 0xf, true)); }
template <int O> DI float shx(float v) {
  if (O == 1) return dpp<0xB1>(v);
  if (O == 2) return dpp<0x4E>(v);
  return swz<O>(v);
}
DI float row16_max(float v) { v = fmaxf(v, dpp<0xB1>(v)); v = fmaxf(v, dpp<0x4E>(v)); v = fmaxf(v, dpp<0x141>(v)); v = fmaxf(v, dpp<0x140>(v)); return v; }
DI float row16_sum(float v) { v += dpp<0xB1>(v); v += dpp<0x4E>(v); v += dpp<0x141>(v); v += dpp<0x140>(v); return v; }
DI float shfl_lane(float v, int src) { return __int_as_float(__builtin_amdgcn_ds_bpermute(src << 2, __float_as_int(v))); }
DI int otid512(int wv) { int t = wv * 64 + lane_id(); asm volatile("" : "+v"(t)); return t; }
DI int otid(int wv) { return otid512(wv) & 255; }
template <int CTRL, int RMASK> DI float dpp_old(float old, float v) { return __int_as_float(__builtin_amdgcn_update_dpp(__float_as_int(old), __float_as_int(v), CTRL, RMASK, 0xf, false)); }
DI float wave_scan_sum(float v) {
  v += dpp_old<0x111, 0xf>(0.f, v); v += dpp_old<0x112, 0xf>(0.f, v); v += dpp_old<0x114, 0xf>(0.f, v); v += dpp_old<0x118, 0xf>(0.f, v);
  v += dpp_old<0x142, 0xa>(0.f, v);
  v += dpp_old<0x143, 0xc>(0.f, v);
  return v;
}
DI float wave_scan_max(float v) {
  const float ni = -INFINITY;
  v = fmaxf(v, dpp_old<0x111, 0xf>(ni, v)); v = fmaxf(v, dpp_old<0x112, 0xf>(ni, v)); v = fmaxf(v, dpp_old<0x114, 0xf>(ni, v)); v = fmaxf(v, dpp_old<0x118, 0xf>(ni, v));
  v = fmaxf(v, dpp_old<0x142, 0xa>(ni, v));
  v = fmaxf(v, dpp_old<0x143, 0xc>(ni, v));
  return v;
}
DI float wave_sum(float v) {
  v = row16_sum(v); v += swz<16>(v);
  v += shfl_lane(v, lane_id() ^ 32);
  return v;
}
DI float half_max(float v) { v = row16_max(v); return fmaxf(v, swz<16>(v)); }
DI float half_sum(float v) { v = row16_sum(v); return v + swz<16>(v); }
DI int crow(int i, int h) { return (i & 3) + 8 * (i >> 2) + 4 * h; }

DI void load8bf(const bf16_t* src, float* v) {
  uint4 u = *(const uint4*)src;
  v[0] = __uint_as_float(u.x << 16); v[1] = __uint_as_float(u.x & 0xffff0000u);
  v[2] = __uint_as_float(u.y << 16); v[3] = __uint_as_float(u.y & 0xffff0000u);
  v[4] = __uint_as_float(u.z << 16); v[5] = __uint_as_float(u.z & 0xffff0000u);
  v[6] = __uint_as_float(u.w << 16); v[7] = __uint_as_float(u.w & 0xffff0000u);
}
DI void load32bf(const bf16_t* src, float* v) {
#pragma unroll
  for (int q = 0; q < 4; ++q) load8bf(src + q * 8, v + q * 8);
}
DI void store32bf(bf16_t* dst, const float* v) {
#pragma unroll
  for (int q = 0; q < 4; ++q) {
    uint4 u;
    u.x = pack2(v[q * 8 + 0], v[q * 8 + 1]); u.y = pack2(v[q * 8 + 2], v[q * 8 + 3]);
    u.z = pack2(v[q * 8 + 4], v[q * 8 + 5]); u.w = pack2(v[q * 8 + 6], v[q * 8 + 7]);
    *(uint4*)(dst + q * 8) = u;
  }
}
DI void rope32(float* v, int half, const float* rr) {
#pragma unroll
  for (int q = 0; q < 8; ++q) {
    float4 c4 = *(const float4*)(rr + q * 4);
    float4 s4 = *(const float4*)(rr + 32 + q * 4);
    float cc[4] = {c4.x, c4.y, c4.z, c4.w}, ss[4] = {s4.x, s4.y, s4.z, s4.w};
#pragma unroll
    for (int j = 0; j < 4; ++j) {
      float x = v[q * 4 + j];
      float o = shx<1>(x);
      v[q * 4 + j] = half ? (x * cc[j] + o * ss[j]) : (x * cc[j] - o * ss[j]);
    }
  }
}
DI void conv_silu32(const bf16_t* rowp, bool hp, bool hn, const float* cw, const float* cb, float scale, float* v) {
#pragma unroll
  for (int q = 0; q < 4; ++q) {
    float x0[8], xm[8], xp[8];
    load8bf(rowp + q * 8, x0);
    if (hp) load8bf(rowp - 4096 + q * 8, xm); else {
#pragma unroll
      for (int j = 0; j < 8; ++j) xm[j] = 0.f; }
    if (hn) load8bf(rowp + 4096 + q * 8, xp); else {
#pragma unroll
      for (int j = 0; j < 8; ++j) xp[j] = 0.f; }
#pragma unroll
    for (int g = 0; g < 2; ++g) {
      float4 b4 = *(const float4*)(cb + q * 8 + g * 4);
      float4 w0 = *(const float4*)(cw + q * 8 + g * 4);
      float4 w1 = *(const float4*)(cw + 1024 + q * 8 + g * 4);
      float4 w2 = *(const float4*)(cw + 2048 + q * 8 + g * 4);
      float bb[4] = {b4.x, b4.y, b4.z, b4.w}, a0[4] = {w0.x, w0.y, w0.z, w0.w}, a1[4] = {w1.x, w1.y, w1.z, w1.w}, a2[4] = {w2.x, w2.y, w2.z, w2.w};
#pragma unroll
      for (int j = 0; j < 4; ++j) {
        int e = g * 4 + j;
        float y = bb[j] + a0[j] * xm[e] + a1[j] * x0[e] + a2[j] * xp[e];
        v[q * 8 + e] = siluf_(y) * scale;
      }
    }
  }
}

DI void prep_transpose(int wv, const float* __restrict__ src, int ldsrc, int nvalid, int mode, bf16_t* __restrict__ dst, int K, int n0, int k0, float* lds) {
  const int tid = otid(wv);
  const int n4 = (tid & 15) * 4, kq = tid >> 4;
  const int n = n0 + n4;
  const int col = mode == 1 ? (((n >> 7) & 1) * 2816 + (n >> 8) * 128 + (n & 127))
                : mode == 2 ? ((n & ~255) + ((n >> 5) & 3) * 64 + ((n >> 7) & 1) * 32 + (n & 31)) : n;
  const bool valid = n < nvalid;
#pragma unroll
  for (int sb = 0; sb < 4; ++sb) {
#pragma unroll
    for (int i = 0; i < 4; ++i) {
      const int kk = i * 16 + kq;
      float4 v = make_float4(0.f, 0.f, 0.f, 0.f);
      if (valid) v = *(const float4*)(src + (size_t)(k0 + sb * 64 + kk) * ldsrc + col);
      float* d = lds + sb * 4160 + kk * 65 + n4;
      d[0] = v.x; d[1] = v.y; d[2] = v.z; d[3] = v.w;
    }
  }
  __syncthreads();
  const int k8 = (tid & 7) * 8, nq = tid >> 3;
#pragma unroll
  for (int sb = 0; sb < 4; ++sb) {
#pragma unroll
    for (int i = 0; i < 2; ++i) {
      const int n2 = i * 32 + nq;
      const float* c = lds + sb * 4160 + k8 * 65 + n2;
      uint4 o;
      o.x = pack2(c[0], c[65]); o.y = pack2(c[130], c[195]); o.z = pack2(c[260], c[325]); o.w = pack2(c[390], c[455]);
      *(uint4*)&dst[(size_t)(n0 + n2) * K + k0 + sb * 64 + k8] = o;
    }
  }
  __syncthreads();
}

DI void prep_mod(int wv, KP p, int item, float* lds) {
  const int tid = otid(wv);
  const int layer = item / 192, cb = item % 192;
  float* sv = lds;
  for (int i = tid; i < 3072; i += 256) {
    int v = i >> 10, k = i & 1023;
    float x = (v < 2) ? p->in[1][v * 1024 + k] : p->in[3][k];
    sv[i] = x / (1.f + expf(-x));
  }
  __syncthreads();
  const int kq = tid >> 3, c4 = tid & 7;
  const float* W = p->in[4] + (size_t)layer * 1024 * 6144 + cb * 32 + c4 * 4;
  float acc[3][4];
#pragma unroll
  for (int v = 0; v < 3; ++v)
#pragma unroll
    for (int j = 0; j < 4; ++j) acc[v][j] = 0.f;
#pragma unroll 8
  for (int i = 0; i < 32; ++i) {
    int k = kq * 32 + i;
    float4 w = *(const float4*)(W + (size_t)k * 6144);
#pragma unroll
    for (int v = 0; v < 3; ++v) {
      float s_ = sv[v * 1024 + k];
      acc[v][0] += s_ * w.x; acc[v][1] += s_ * w.y; acc[v][2] += s_ * w.z; acc[v][3] += s_ * w.w;
    }
  }
  float* red = lds + 3072;
#pragma unroll
  for (int v = 0; v < 3; ++v)
#pragma unroll
    for (int j = 0; j < 4; ++j) red[(kq * 3 + v) * 32 + c4 * 4 + j] = acc[v][j];
  __syncthreads();
  if (tid < 96) {
    int v = tid >> 5, col = tid & 31;
    float s_ = p->in[5][layer * 6144 + cb * 32 + col];
    for (int q = 0; q < 32; ++q) s_ += red[(q * 3 + v) * 32 + col];
    ((float*)(p->ws + OFF_MOD))[(layer * 3 + v) * 6144 + cb * 32 + col] = s_;
  }
  __syncthreads();
}

DI void prep_rope(int wv, KP p, int item) {
  float* rope = (float*)(p->ws + OFF_ROPE);
#pragma unroll 1
  for (int i = 0; i < 16; ++i) {
    int e = item * 4096 + i * 256 + otid(wv);
    int t = e >> 5, j = e & 31;
    int row = t >> 6, col = t & 63;
    float inv = powf(10000.f, -(float)(j & 15) / 16.f);
    float ang = (float)(j < 16 ? row : col) * inv;
    rope[t * 64 + j] = cosf(ang);
    rope[t * 64 + 32 + j] = sinf(ang);
  }
}

DI void phase_prep_tr(int wv, KP p, int item, char* smem) {
  float* lds = (float*)smem;
  const float* src; int ld, nvalid, mode, K, tk; bf16_t* dst; int j = item;
  if (j < 64) { src = p->in[10]; ld = 1024; nvalid = 1024; mode = 0; K = 1024; tk = 4; dst = (bf16_t*)(p->ws + OFF_WOUT0); }
  else if ((j -= 64) < 704) { int l = j / 352; j -= l * 352; src = p->in[7] + (size_t)l * 1024 * 5632; ld = 5632; nvalid = 5632; mode = 1; K = 1024; tk = 4; dst = (bf16_t*)(p->ws + OFF_WFI) + (size_t)l * 5632 * 1024; }
  else if ((j -= 704) < 352) { int l = j / 176; j -= l * 176; src = p->in[8] + (size_t)l * 2816 * 1024; ld = 1024; nvalid = 1024; mode = 0; K = 2816; tk = 11; dst = (bf16_t*)(p->ws + OFF_WFO) + (size_t)l * 1024 * 2816; }
  else if ((j -= 352) < 96) { src = p->in[17]; ld = 1536; nvalid = 1536; mode = 2; K = 1024; tk = 4; dst = (bf16_t*)(p->ws + OFF_WAI); }
  else if ((j -= 96) < 64) { src = p->in[18]; ld = 1024; nvalid = 1024; mode = 0; K = 1024; tk = 4; dst = (bf16_t*)(p->ws + OFF_WAO); }
  else { j -= 64; src = p->in[9]; ld = 4128; nvalid = 4128; mode = 0; K = 1024; tk = 4; dst = (bf16_t*)(p->ws + OFF_WIN0); }
  int nt = j / tk, kt = j % tk;
  prep_transpose(wv, src, ld, nvalid, mode, dst, K, nt * 64, kt * 256, lds);
}
constexpr int N_PREP_TR = 272 + 64 + 704 + 352 + 96 + 64;

DI void norm_mod_item(int wv, const float* __restrict__ srcLat, const float* __restrict__ srcCtx, const float* __restrict__ nw,
                      const float* __restrict__ mod, int shOff, bf16_t* __restrict__ dst, int item, float* __restrict__ copyCtx = nullptr) {
  const int t512 = otid512(wv);
  const int w = t512 >> 6, lane = t512 & 63;
  const int row = item * 16 + w * 2;
  const float* src = row < NLAT ? srcLat + (size_t)row * 1024 : srcCtx + (size_t)(row - NLAT) * 1024;
  const int v = row < NLAT ? (row >> 13) : 2;
  const float* sh = mod + v * 6144 + shOff;
  const float* sc = sh + 1024;
  float4 x0[4], x1[4], w4[4], s4[4], h4[4];
#pragma unroll
  for (int i = 0; i < 4; ++i) { x0[i] = ((const float4*)src)[lane + 64 * i]; x1[i] = ((const float4*)(src + 1024))[lane + 64 * i]; }
#pragma unroll
  for (int i = 0; i < 4; ++i) { w4[i] = ((const float4*)nw)[lane + 64 * i]; s4[i] = ((const float4*)sc)[lane + 64 * i]; h4[i] = ((const float4*)sh)[lane + 64 * i]; }
  if (copyCtx != nullptr && row >= NLAT) {
#pragma unroll
    for (int i = 0; i < 4; ++i) { ((float4*)(copyCtx + (size_t)(row - NLAT) * 1024))[lane + 64 * i] = x0[i]; ((float4*)(copyCtx + (size_t)(row - NLAT + 1) * 1024))[lane + 64 * i] = x1[i]; }
  }
  float ss0 = 0.f, ss1 = 0.f;
#pragma unroll
  for (int i = 0; i < 4; ++i) {
    ss0 += x0[i].x * x0[i].x + x0[i].y * x0[i].y + x0[i].z * x0[i].z + x0[i].w * x0[i].w;
    ss1 += x1[i].x * x1[i].x + x1[i].y * x1[i].y + x1[i].z * x1[i].z + x1[i].w * x1[i].w;
  }
  ss0 = wave_sum(ss0); ss1 = wave_sum(ss1);
  const float r0 = rsqrtf(ss0 * (1.f / 1024.f) + 1e-6f), r1 = rsqrtf(ss1 * (1.f / 1024.f) + 1e-6f);
#pragma unroll
  for (int i = 0; i < 4; ++i) {
    const int c4 = lane + 64 * i;
    const float m0 = w4[i].x * (1.f + s4[i].x), m1 = w4[i].y * (1.f + s4[i].y), m2 = w4[i].z * (1.f + s4[i].z), m3 = w4[i].w * (1.f + s4[i].w);
    uint2 o;
    o.x = pack2(x0[i].x * r0 * m0 + h4[i].x, x0[i].y * r0 * m1 + h4[i].y);
    o.y = pack2(x0[i].z * r0 * m2 + h4[i].z, x0[i].w * r0 * m3 + h4[i].w);
    *(uint2*)(dst + (size_t)row * 1024 + c4 * 4) = o;
    o.x = pack2(x1[i].x * r1 * m0 + h4[i].x, x1[i].y * r1 * m1 + h4[i].y);
    o.y = pack2(x1[i].z * r1 * m2 + h4[i].z, x1[i].w * r1 * m3 + h4[i].w);
    *(uint2*)(dst + (size_t)(row + 1) * 1024 + c4 * 4) = o;
  }
}

enum { EPI_P0 = 0, EPI_RES = 1, EPI_SWIGLU = 2, EPI_STORE = 3, EPI_QKV = 4 };
struct EpiArgs {
  bf16_t* obf;
  int ldo;
  float* of32;
  float* of32c;
  const float* resLat;
  const float* resCtx;
  const float* gvec;
  const float* bias;
};

typedef float f32x4 __attribute__((ext_vector_type(4)));
constexpr int G_HT = 128 * 64;
DI int lds_byte(int r, int c) {
  int st = (r >> 4) * 2 + (c >> 5), rr = r & 15, cc = c & 31, ob = rr * 64 + cc * 2;
  return st * 1024 + (ob ^ (((ob >> 9) & 1) << 5));
}
DI void stage_rc(int b, int& R, int& C) {
  int st = b / 1024, sb = b % 1024, swz = sb ^ (((sb >> 9) & 1) << 5);
  R = (st >> 1) * 16 + swz / 64; C = (st & 1) * 32 + (swz % 64) / 2;
}

template <int EPI, bool SPLIT>
DI void gemm_phase(int wv, const bf16_t* __restrict__ A, const bf16_t* __restrict__ Bt, int M, int N, int K, const EpiArgs& ea, char* smem, int Mfull = -1, int ksplit = 1) {
  bf16_t* shm = (bf16_t*)smem;
#define SA(b, h) (shm + ((b) * 2 + (h)) * G_HT)
#define SB(b, h) (shm + (4 + (b) * 2 + (h)) * G_HT)
#define STAGE(P, BASE, br, kt) do { const long _g = (long)(br) * K + (long)(kt) * 64 + kofs; \
    _Pragma("unroll") for (int _i = 0; _i < 2; ++_i) { const int _b = tix * 16 + _i * 8192; \
      __builtin_amdgcn_global_load_lds((const unsigned*)((BASE) + _g + (long)srow[_i] * K + scol[_i]), \
        (__attribute__((address_space(3))) unsigned*)((char*)(P) + _b), 16, 0, 0); } } while (0)
#define LDA(dst, b, h) _Pragma("unroll") for (int m = 0; m < 4; ++m) _Pragma("unroll") for (int k = 0; k < 2; ++k) \
    dst[m][k] = *reinterpret_cast<const bf16x8*>((char*)SA(b, h) + lds_byte(wr * 64 + m * 16 + fr, k * 32 + fq * 8))
#define LDB(dst, b, h) _Pragma("unroll") for (int n = 0; n < 2; ++n) _Pragma("unroll") for (int k = 0; k < 2; ++k) \
    dst[n][k] = *reinterpret_cast<const bf16x8*>((char*)SB(b, h) + lds_byte(wc * 32 + n * 16 + fr, k * 32 + fq * 8))
#define MMA(ai, bj, At_, Bt_) do { __builtin_amdgcn_s_setprio(1); \
    _Pragma("unroll") for (int m = 0; m < 4; ++m) _Pragma("unroll") for (int n = 0; n < 2; ++n) _Pragma("unroll") for (int k = 0; k < 2; ++k) \
      acc[ai][bj][m][n] = __builtin_amdgcn_mfma_f32_16x16x32_bf16(Bt_[n][k], At_[m][k], acc[ai][bj][m][n], 0, 0, 0); \
    __builtin_amdgcn_s_setprio(0); } while (0)
#define WAIT_V(n) asm volatile("s_waitcnt vmcnt(" #n ")" ::: "memory")
#define WAIT_L(n) asm volatile("s_waitcnt lgkmcnt(" #n ")" ::: "memory")
#define BAR __builtin_amdgcn_s_barrier()
#define SCHED __builtin_amdgcn_sched_barrier(0)
  if (Mfull < 0) Mfull = M;
  const int nM = Mfull / 256, nN = N / 256, nwg = nM * nN;
  int nunits = nwg;
  if constexpr (SPLIT) nunits += ((M - Mfull) / 256) * nN * ksplit;
  int G = gridDim.x, Lb = blockIdx.x;
  asm volatile("" : "+s"(G), "+s"(Lb));
  for (int L = Lb; L < nunits; L += G) {
    const int tix = otid512(wv);
    const int wid = tix >> 6, lane = tix & 63, wr = wid >> 2, wc = wid & 3, fr = lane & 15, fq = lane >> 4;
    int srow[2], scol[2];
    stage_rc(tix * 16, srow[0], scol[0]);
    stage_rc(tix * 16 + 8192, srow[1], scol[1]);
    int brow, bcol, kofs = 0, nt = K / 64;
    bool split = false;
    if constexpr (SPLIT) split = L >= nwg;
    if (!split) {
      int wgid = L;
      { const int q = nwg / 8, r = nwg % 8, xcd = wgid % 8, off = wgid / 8; wgid = (xcd < r ? xcd * (q + 1) : r * (q + 1) + (xcd - r) * q) + off; }
      const int nig = 8 * nN, gid = wgid / nig, fm = gid * 8, gsz = (nM - fm) < 8 ? (nM - fm) : 8;
      const int pm = fm + ((wgid % nig) % gsz), pn = (wgid % nig) / gsz;
      brow = pm * 256; bcol = pn * 256;
    } else {
      const int u = L - nwg, ks = u % ksplit, tile = u / ksplit;
      brow = Mfull + (tile / nN) * 256; bcol = (tile % nN) * 256;
      nt = nt / ksplit; kofs = ks * nt * 64;
    }
    f32x4 acc[2][2][4][2];
#pragma unroll
    for (int a0 = 0; a0 < 2; ++a0)
#pragma unroll
      for (int a1 = 0; a1 < 2; ++a1)
#pragma unroll
        for (int a2 = 0; a2 < 4; ++a2)
#pragma unroll
          for (int a3 = 0; a3 < 2; ++a3) acc[a0][a1][a2][a3] = f32x4{0.f, 0.f, 0.f, 0.f};
    bf16x8 At[4][2], B0[2][2], B1[2][2];
    STAGE(SB(0, 0), Bt, bcol, 0); STAGE(SA(0, 0), A, brow, 0);
    STAGE(SB(0, 1), Bt, bcol + 128, 0); STAGE(SA(0, 1), A, brow + 128, 0);
    if (wr == 1) BAR;
    WAIT_V(4); BAR;
    STAGE(SB(1, 0), Bt, bcol, 1); STAGE(SA(1, 0), A, brow, 1); STAGE(SB(1, 1), Bt, bcol + 128, 1);
    WAIT_V(6); BAR;
    for (int t = 0; t < nt - 2; t += 2) {
      LDB(B0, 0, 0); SCHED; LDA(At, 0, 0); STAGE(SA(1, 1), A, brow + 128, t + 1);
      WAIT_L(8); BAR; WAIT_L(0); MMA(0, 0, At, B0); BAR; SCHED;
      LDB(B1, 0, 1); STAGE(SB(0, 0), Bt, bcol, t + 2);
      BAR; WAIT_L(0); MMA(0, 1, At, B1); BAR;
      LDA(At, 0, 1); STAGE(SA(0, 0), A, brow, t + 2);
      BAR; WAIT_L(0); MMA(1, 0, At, B0); BAR; SCHED;
      STAGE(SB(0, 1), Bt, bcol + 128, t + 2);
      WAIT_V(6); BAR; MMA(1, 1, At, B1); BAR;
      LDB(B0, 1, 0); SCHED; LDA(At, 1, 0); STAGE(SA(0, 1), A, brow + 128, t + 2);
      WAIT_L(8); BAR; WAIT_L(0); MMA(0, 0, At, B0); BAR; SCHED;
      LDB(B1, 1, 1); STAGE(SB(1, 0), Bt, bcol, t + 3);
      BAR; WAIT_L(0); MMA(0, 1, At, B1); BAR;
      LDA(At, 1, 1); STAGE(SA(1, 0), A, brow, t + 3);
      BAR; WAIT_L(0); MMA(1, 0, At, B0); BAR; SCHED;
      STAGE(SB(1, 1), Bt, bcol + 128, t + 3);
      WAIT_V(6); BAR; MMA(1, 1, At, B1); BAR;
    }
    { LDB(B0, 0, 0); LDA(At, 0, 0); STAGE(SA(1, 1), A, brow + 128, nt - 1);
      BAR; WAIT_L(0); MMA(0, 0, At, B0); BAR;
      LDB(B1, 0, 1); BAR; WAIT_L(0); MMA(0, 1, At, B1); BAR;
      LDA(At, 0, 1); WAIT_V(4); BAR; WAIT_L(0); MMA(1, 0, At, B0); MMA(1, 1, At, B1); BAR; }
    { LDB(B0, 1, 0); LDA(At, 1, 0); WAIT_V(2); BAR; WAIT_L(0); MMA(0, 0, At, B0); BAR;
      LDB(B1, 1, 1); WAIT_V(0); BAR; WAIT_L(0); MMA(0, 1, At, B1); BAR;
      LDA(At, 1, 1); BAR; WAIT_L(0); MMA(1, 0, At, B0); MMA(1, 1, At, B1); BAR; }
    if (wr == 0) BAR;
    float* obase = nullptr; const float* rbase = nullptr; const float* gv = nullptr;
    if (EPI == EPI_RES) {
      const bool isc = brow >= NLAT;
      obase = isc ? ea.of32c - (size_t)NLAT * 1024 : ea.of32;
      rbase = isc ? ea.resCtx - (size_t)NLAT * 1024 : ea.resLat;
      gv = ea.gvec + (isc ? 2 : (brow >> 13)) * 6144;
    }
#pragma unroll
    for (int ai = 0; ai < 2; ++ai)
#pragma unroll
      for (int m = 0; m < 4; ++m) {
        const int row = brow + ai * 128 + wr * 64 + m * 16 + fr;
        if (EPI == EPI_QKV) {
          float x[2][2][4];
#pragma unroll
          for (int bj = 0; bj < 2; ++bj)
#pragma unroll
            for (int n = 0; n < 2; ++n)
#pragma unroll
              for (int j = 0; j < 4; ++j) x[bj][n][j] = acc[ai][bj][m][n][j];
          if (bcol < 1280) {
            float ss = 0.f;
#pragma unroll
            for (int bj = 0; bj < 2; ++bj)
#pragma unroll
              for (int n = 0; n < 2; ++n)
#pragma unroll
                for (int j = 0; j < 4; ++j) ss += x[bj][n][j] * x[bj][n][j];
            ss += swz<16>(ss);
            ss += shfl_lane(ss, lane ^ 32);
            const float rstd = rsqrtf(ss * (1.f / 64.f) + 1e-6f);
            const float* nwp = (bcol < 1024 ? ea.bias : ea.gvec) + fq * 4;
            const float sc_ = bcol < 1024 ? 0.125f * 1.44269504f : 1.f;
            const bool dorope = row < NLAT;
            const float* rr = ea.resLat + (size_t)(row & 8191) * 64 + fq * 4;
#pragma unroll
            for (int n = 0; n < 2; ++n) {
              const float4 w1 = *(const float4*)(nwp + n * 16), w2 = *(const float4*)(nwp + 32 + n * 16);
              float4 c4 = make_float4(1.f, 1.f, 1.f, 1.f), s4 = make_float4(0.f, 0.f, 0.f, 0.f);
              if (dorope) { c4 = *(const float4*)(rr + n * 16); s4 = *(const float4*)(rr + 32 + n * 16); }
              const float wa[4] = {w1.x, w1.y, w1.z, w1.w}, wb[4] = {w2.x, w2.y, w2.z, w2.w}, cc[4] = {c4.x, c4.y, c4.z, c4.w}, sn[4] = {s4.x, s4.y, s4.z, s4.w};
#pragma unroll
              for (int j = 0; j < 4; ++j) {
                const float y1 = x[0][n][j] * rstd * wa[j], y2 = x[1][n][j] * rstd * wb[j];
                x[0][n][j] = (y1 * cc[j] - y2 * sn[j]) * sc_;
                x[1][n][j] = (y2 * cc[j] + y1 * sn[j]) * sc_;
              }
            }
          }
#pragma unroll
          for (int bj = 0; bj < 2; ++bj)
#pragma unroll
            for (int n = 0; n < 2; ++n) {
              uint2 o; o.x = pack2(x[bj][n][0], x[bj][n][1]); o.y = pack2(x[bj][n][2], x[bj][n][3]);
              *(uint2*)&ea.obf[(size_t)row * 1536 + bcol + wc * 64 + bj * 32 + n * 16 + fq * 4] = o;
            }
        } else if (EPI == EPI_SWIGLU) {
#pragma unroll
          for (int n = 0; n < 2; ++n) {
            const f32x4 g = acc[ai][0][m][n], u = acc[ai][1][m][n];
            uint2 o;
            o.x = pack2(siluf_(g[0]) * u[0], siluf_(g[1]) * u[1]);
            o.y = pack2(siluf_(g[2]) * u[2], siluf_(g[3]) * u[3]);
            *(uint2*)&ea.obf[(size_t)row * ea.ldo + (bcol >> 1) + wc * 32 + n * 16 + fq * 4] = o;
          }
        } else {
#pragma unroll
          for (int bj = 0; bj < 2; ++bj)
#pragma unroll
            for (int n = 0; n < 2; ++n) {
              const int col = bcol + bj * 128 + wc * 32 + n * 16 + fq * 4;
              const f32x4 val = acc[ai][bj][m][n];
              if (EPI == EPI_P0) {
                if (bcol < 4096) { uint2 o; o.x = pack2(val[0], val[1]); o.y = pack2(val[2], val[3]); *(uint2*)&ea.obf[(size_t)row * 4096 + col] = o; }
                else if (col < 4128) {
                  const float4 bb = *(const float4*)(ea.bias + (col - 4096));
                  float4 o; o.x = val[0] + bb.x; o.y = val[1] + bb.y; o.z = val[2] + bb.z; o.w = val[3] + bb.w;
                  *(float4*)(ea.of32 + (size_t)row * 32 + (col - 4096)) = o;
                }
              } else if (EPI == EPI_RES) {
                const float4 g = *(const float4*)(gv + col);
                float* op = obase + (size_t)row * 1024 + col;
                bool done = false;
                if constexpr (SPLIT) {
                  if (split) { unsafeAtomicAdd(op, g.x * val[0]); unsafeAtomicAdd(op + 1, g.y * val[1]); unsafeAtomicAdd(op + 2, g.z * val[2]); unsafeAtomicAdd(op + 3, g.w * val[3]); done = true; }
                }
                if (!done) {
                  const float4 rr = *(const float4*)(rbase + (size_t)row * 1024 + col);
                  float4 o; o.x = rr.x + g.x * val[0]; o.y = rr.y + g.y * val[1]; o.z = rr.z + g.z * val[2]; o.w = rr.w + g.w * val[3];
                  *(float4*)op = o;
                }
              } else {
                uint2 o; o.x = pack2(val[0], val[1]); o.y = pack2(val[2], val[3]);
                *(uint2*)&ea.obf[(size_t)row * ea.ldo + col] = o;
              }
            }
        }
      }
    WAIT_V(0);
  }
#undef SA
#undef SB
#undef STAGE
#undef LDA
#undef LDB
#undef MMA
}

DI void chunk_rows(int b, int cc, int& row0, int& pos0, int& slen) {
  if (cc < 2) { row0 = NLAT + b * LC + cc * 128; pos0 = cc * 128; slen = LC; }
  else { row0 = b * SEQ + (cc - 2) * 128; pos0 = (cc - 2) * 128; slen = SEQ; }
}
DI int seq_index(int dir, int cc) { return dir == 0 ? cc : (cc < 2 ? 1 - cc : 67 - cc); }

template <bool WITH_ROW>
DI void mlstm_vecs(const float* __restrict__ gates, int row0, int hd, int dir, int lane, float mprev,
                   float* cv, float* rowv, float* av, float* en, float* tot) {
  const int j0 = 2 * lane, j1 = j0 + 1;
  const int p0 = dir ? 127 - j0 : j0, p1 = dir ? 127 - j1 : j1;
  const float* g0 = gates + (size_t)(row0 + p0) * 32 + dir * 16 + hd;
  const float* g1 = gates + (size_t)(row0 + p1) * 32 + dir * 16 + hd;
  const float i0 = g0[0], f0 = g0[8], i1 = g1[0], f1 = g1[8];
  const float lf0 = logsigf_(f0), lf1 = logsigf_(f1);
  const float s = lf0 + lf1;
  const float incl = wave_scan_sum(s);
  const float excl = incl - s;
  const float b0 = excl + lf0, b1 = b0 + lf1;
  const float c0 = i0 - b0, c1 = i1 - b1;
  const float im = wave_scan_max(fmaxf(c0, c1));
  float em = shfl_lane(im, (lane - 1) & 63);
  if (lane == 0) em = -INFINITY;
  if (WITH_ROW) { cv[p0] = c0; cv[p1] = c1; }
  else { const float mxa = shfl_lane(im, 63); cv[p0] = __expf(c0 - mxa); cv[p1] = __expf(c1 - mxa); }
  if (WITH_ROW) {
    const float pm0 = fmaxf(em, c0), pm1 = im;
    const float al0 = b0 + mprev, al1 = b1 + mprev;
    const float mt0 = fmaxf(al0, b0 + pm0), mt1 = fmaxf(al1, b1 + pm1);
    rowv[p0] = b0 - mt0; rowv[p1] = b1 - mt1;
    av[p0] = __expf(al0 - mt0); av[p1] = __expf(al1 - mt1);
    en[p0] = __expf(-mt0); en[p1] = __expf(-mt1);
  }
  if (lane == 63) { tot[0] = incl; tot[1] = im; }
}

DI void load_qk_l0(KP p, int type, int hd, int is_k, int row, int pos, int slen, bool isLat, int half, float scale, float* v) {
  const bf16_t* P0 = (const bf16_t*)(p->ws + OFF_P0);
  if (type == 0) {
    load32bf(P0 + (size_t)row * 4096 + (is_k ? 512 : 0) + hd * 64 + half * 32, v);
    if (isLat) rope32(v, half, (const float*)(p->ws + OFF_ROPE) + (size_t)pos * 64);
#pragma unroll
    for (int i = 0; i < 32; ++i) v[i] *= scale;
  } else {
    const int ch = (is_k ? 512 : 0) + hd * 64 + half * 32;
    conv_silu32(P0 + (size_t)row * 4096 + 2048 + ch, pos > 0, pos < slen - 1, p->in[13] + ch, p->in[14] + ch, scale, v);
  }
}

DI void unpack8(const uint4 u, float* v) {
  v[0] = __uint_as_float(u.x << 16); v[1] = __uint_as_float(u.x & 0xffff0000u);
  v[2] = __uint_as_float(u.y << 16); v[3] = __uint_as_float(u.y & 0xffff0000u);
  v[4] = __uint_as_float(u.z << 16); v[5] = __uint_as_float(u.z & 0xffff0000u);
  v[6] = __uint_as_float(u.w << 16); v[7] = __uint_as_float(u.w & 0xffff0000u);
}
DI void raw_issue(const bf16_t* rowp, int type, bool hp, bool hn, uint4* a) {
  const uint4 z = make_uint4(0u, 0u, 0u, 0u);
#pragma unroll
  for (int q = 0; q < 4; ++q) a[q] = ((const uint4*)rowp)[q];
#pragma unroll
  for (int q = 0; q < 4; ++q) { a[4 + q] = z; a[8 + q] = z; }
  if (type == 1) {
    if (hp) {
#pragma unroll
      for (int q = 0; q < 4; ++q) a[4 + q] = ((const uint4*)(rowp - 4096))[q];
    }
    if (hn) {
#pragma unroll
      for (int q = 0; q < 4; ++q) a[8 + q] = ((const uint4*)(rowp + 4096))[q];
    }
  }
}
DI void raw_process(KP p, int type, int hd, int is_k, int pos, bool isLat, int half, float scale, const uint4* a, float* v) {
  if (type == 0) {
#pragma unroll
    for (int q = 0; q < 4; ++q) unpack8(a[q], v + q * 8);
    if (isLat) rope32(v, half, (const float*)(p->ws + OFF_ROPE) + (size_t)pos * 64);
#pragma unroll
    for (int i = 0; i < 32; ++i) v[i] *= scale;
  } else {
    const int ch = (is_k ? 512 : 0) + hd * 64 + half * 32;
    const float* cw = p->in[13] + ch; const float* cb = p->in[14] + ch;
#pragma unroll
    for (int q = 0; q < 4; ++q) {
      float x0[8], xm[8], xp[8];
      unpack8(a[q], x0); unpack8(a[4 + q], xm); unpack8(a[8 + q], xp);
#pragma unroll
      for (int g = 0; g < 2; ++g) {
        const float4 b4 = *(const float4*)(cb + q * 8 + g * 4);
        const float4 w0 = *(const float4*)(cw + q * 8 + g * 4);
        const float4 w1 = *(const float4*)(cw + 1024 + q * 8 + g * 4);
        const float4 w2 = *(const float4*)(cw + 2048 + q * 8 + g * 4);
        const float bb[4] = {b4.x, b4.y, b4.z, b4.w}, a0[4] = {w0.x, w0.y, w0.z, w0.w}, a1[4] = {w1.x, w1.y, w1.z, w1.w}, a2[4] = {w2.x, w2.y, w2.z, w2.w};
#pragma unroll
        for (int j = 0; j < 4; ++j) {
          const int e = g * 4 + j;
          const float y = bb[j] + a0[j] * xm[e] + a1[j] * x0[e] + a2[j] * xp[e];
          v[q * 8 + e] = siluf_(y) * scale;
        }
      }
    }
  }
}

DI void phase_kvlocal(int wv, KP p, int item, char* smem) {
  const int tid = otid(wv), lane = tid & 63, w = tid >> 6;
  const int cc = item % NCH, hh = (item / NCH) & 15, b = item / (NCH * 16);
  const int type = hh >> 3, hd = hh & 7;
  int row0, pos0, slen; chunk_rows(b, cc, row0, pos0, slen);
  const bool isLat = cc >= 2;
  bf16_t* sKT = (bf16_t*)smem;
  bf16_t* sVT = sKT + 2 * 64 * LDP;
  float* wgt = (float*)(sVT + 64 * LDP);
  float* tot = wgt + 256;
  const float* gates = (const float*)(p->ws + OFF_GATES);
  if (type == 0) {
    const int dir = tid >> 7, t = tid & 127;
    const float lg = p->in[11][dir * 8 + hd];
    wgt[tid] = dir ? expf(lg * (float)t) : expf(lg * (float)(127 - t));
  } else {
    if (w < 2) mlstm_vecs<false>(gates, row0, hd, w, lane, 0.f, wgt + w * 128, nullptr, nullptr, nullptr, tot + w * 2);
  }
  __syncthreads();
  {
    const int t = tid >> 1, half = tid & 1;
    float kv[32];
    const bf16_t* P0 = (const bf16_t*)(p->ws + OFF_P0);
    const uint4* vp = (const uint4*)(P0 + (size_t)(row0 + t) * 4096 + (type ? 3072 : 1024) + hd * 64 + half * 32);
    const uint4 v0 = vp[0], v1 = vp[1], v2 = vp[2], v3 = vp[3];
    load_qk_l0(p, type, hd, 1, row0 + t, pos0 + t, slen, isLat, half, 0.125f, kv);
    const float w0 = wgt[t], w1 = wgt[128 + t];
#pragma unroll
    for (int i = 0; i < 32; ++i) {
      const int d = half * 32 + i;
      sKT[d * LDP + t] = f2bf(kv[i] * w0);
      sKT[64 * LDP + d * LDP + t] = f2bf(kv[i] * w1);
    }
#define V_SC3(q, vr) do { \
    sVT[(half * 32 + (q) * 8 + 0) * LDP + t] = (bf16_t)((vr).x & 0xffffu); sVT[(half * 32 + (q) * 8 + 1) * LDP + t] = (bf16_t)((vr).x >> 16); \
    sVT[(half * 32 + (q) * 8 + 2) * LDP + t] = (bf16_t)((vr).y & 0xffffu); sVT[(half * 32 + (q) * 8 + 3) * LDP + t] = (bf16_t)((vr).y >> 16); \
    sVT[(half * 32 + (q) * 8 + 4) * LDP + t] = (bf16_t)((vr).z & 0xffffu); sVT[(half * 32 + (q) * 8 + 5) * LDP + t] = (bf16_t)((vr).z >> 16); \
    sVT[(half * 32 + (q) * 8 + 6) * LDP + t] = (bf16_t)((vr).w & 0xffffu); sVT[(half * 32 + (q) * 8 + 7) * LDP + t] = (bf16_t)((vr).w >> 16); } while (0)
    V_SC3(0, v0); V_SC3(1, v1); V_SC3(2, v2); V_SC3(3, v3);
#undef V_SC3
  }
  __syncthreads();
  const int wm = w >> 1, wn = w & 1, r = lane & 31, h = lane >> 5;
  bf16_t* SB = (bf16_t*)(p->ws + OFF_SBUF);
#pragma unroll
  for (int dir = 0; dir < 2; ++dir) {
    f32x16 acc;
#pragma unroll
    for (int i = 0; i < 16; ++i) acc[i] = 0.f;
#pragma unroll
    for (int ks = 0; ks < 8; ++ks) {
      bf16x8 a = *(const bf16x8*)&sKT[dir * 64 * LDP + (wm * 32 + r) * LDP + ks * 16 + h * 8];
      bf16x8 bb = *(const bf16x8*)&sVT[(wn * 32 + r) * LDP + ks * 16 + h * 8];
      acc = MFMA32(a, bb, acc);
    }
    const int sq = ((type * 2 + dir) * 2 + b) * 8 + hd;
    const int si = seq_index(dir, cc);
    bf16_t* dst = SB + ((size_t)sq * NCH + si) * 4096 + (wn * 32 + r) * 64 + wm * 32 + 4 * h;
#pragma unroll
    for (int g = 0; g < 4; ++g) {
      uint2 o; o.x = pack2(acc[4 * g], acc[4 * g + 1]); o.y = pack2(acc[4 * g + 2], acc[4 * g + 3]);
      *(uint2*)(dst + 8 * g) = o;
    }
  }
  if (type == 1 && tid < 128) {
    const int dir = tid >> 6, d = tid & 63;
    const bf16_t* rowp = sKT + dir * 64 * LDP + d * LDP;
    float s = 0.f;
    for (int q = 0; q < 16; ++q) {
      float x[8]; load8bf(rowp + q * 8, x);
#pragma unroll
      for (int j = 0; j < 8; ++j) s += x[j];
    }
    const int sq = ((2 + dir) * 2 + b) * 8 + hd;
    const int si = seq_index(dir, cc);
    ((float*)(p->ws + OFF_NBUF))[((size_t)sq * NCH + si) * 64 + d] = s;
    if (d == 0) {
      float* sc = (float*)(p->ws + OFF_SCAL) + ((size_t)sq * NCH + si) * 2;
      sc[0] = tot[dir * 2] + tot[dir * 2 + 1];
      sc[1] = tot[dir * 2];
    }
  }
  __syncthreads();
}

DI void phase_scan(int wv, KP p, int item) {
  const int tid = otid(wv);
  const int sq = item / 17, blk = item % 17;
  const int type = sq >> 5, dir = (sq >> 4) & 1, hd = sq & 7;
  const float* scal = (const float*)(p->ws + OFF_SCAL) + (size_t)sq * NCH * 2;
  const float adec = type == 0 ? expf(p->in[11][dir * 8 + hd] * 128.f) : 0.f;
  float* mp = (float*)(p->ws + OFF_MPREV) + (size_t)sq * NCH;
  if (blk < 16) {
    bf16_t* ptr = (bf16_t*)(p->ws + OFF_SBUF) + (size_t)sq * NCH * 4096 + blk * 256 + tid;
    float st = 0.f, m = 0.f;
#pragma unroll 1
    for (int n0 = 0; n0 < NCH; n0 += 22) {
      float kv[22];
#pragma unroll
      for (int j = 0; j < 22; ++j) kv[j] = bf2f(ptr[(size_t)(n0 + j) * 4096]);
#pragma unroll
      for (int j = 0; j < 22; ++j) {
        const int n = n0 + j;
        float a, bb;
        if (type == 0) { a = adec; bb = 1.f; }
        else {
          const float gm = scal[n * 2], be = scal[n * 2 + 1];
          const float mn = fmaxf(be + m, gm);
          a = __expf(be + m - mn); bb = __expf(gm - mn);
          m = mn;
        }
        ptr[(size_t)n * 4096] = f2bf(st);
        st = a * st + bb * kv[j];
      }
    }
  } else {
    if (type == 0 || tid > 64) return;
    float* ptr = (float*)(p->ws + OFF_NBUF) + (size_t)sq * NCH * 64 + (tid & 63);
    const bool active = tid < 64, wm = tid == 64;
    float st = 0.f, m = 0.f;
#pragma unroll 1
    for (int n0 = 0; n0 < NCH; n0 += 22) {
      float kv[22];
#pragma unroll
      for (int j = 0; j < 22; ++j) kv[j] = active ? ptr[(size_t)(n0 + j) * 64] : 0.f;
#pragma unroll
      for (int j = 0; j < 22; ++j) {
        const int n = n0 + j;
        const float gm = scal[n * 2], be = scal[n * 2 + 1];
        const float mn = fmaxf(be + m, gm);
        const float a = __expf(be + m - mn), bb = __expf(gm - mn);
        if (wm) mp[n] = m;
        m = mn;
        if (active) ptr[(size_t)n * 64] = st;
        st = a * st + bb * kv[j];
      }
    }
  }
}

DI void phase_chunkout(int wv, KP p, int item, char* smem, bf16_t* __restrict__ MRG) {
  const int tid = otid(wv), lane = tid & 63, w = tid >> 6;
  const int cc = item % NCH, hh = (item / NCH) & 15, b = item / (NCH * 16);
  const int type = hh >> 3, hd = hh & 7;
  int row0, pos0, slen; chunk_rows(b, cc, row0, pos0, slen);
  const bool isLat = cc >= 2;
  bf16_t* sQ = (bf16_t*)smem;
  bf16_t* sK = sQ + 128 * LDT;
  bf16_t* sVT = sK + 128 * LDT;
  bf16_t* sCT = sVT + 64 * LDP;
  float* vec = (float*)(sCT + 2 * 64 * LDT);
  float* rowv = vec;
  float* colv = vec + 256;
  float* av = vec + 512;
  float* en = vec + 768;
  float* qn = vec + 1024;
  float* rsum = vec + 1280;
  float* tot = vec + 1536;
  float* npv = vec + 1540;
  bf16_t* sP = (bf16_t*)smem;
  float* sO = (float*)smem;
  const bf16_t* P0 = (const bf16_t*)(p->ws + OFF_P0);
  const float* gates = (const float*)(p->ws + OFF_GATES);
#define SQD(dir) (((type * 2 + (dir)) * 2 + b) * 8 + hd)
#define SID(dir) seq_index((dir), cc)
  uint4 gr[4];
  {
    const int t = tid >> 1, half = tid & 1;
    const int d = tid >> 2, e0 = (tid & 3) * 16;
    const int pos = pos0 + t;
    const bool hp = pos > 0, hn = pos < slen - 1;
    const bf16_t* rowb = P0 + (size_t)(row0 + t) * 4096 + hd * 64 + half * 32;
    uint4 qr[12], kr[12], vr[4];
    uint4 cx00, cx01, cx10, cx11;
    raw_issue(rowb + (type ? 2048 : 0), type, hp, hn, qr);
    raw_issue(rowb + (type ? 2560 : 512), type, hp, hn, kr);
#pragma unroll
    for (int q = 0; q < 4; ++q) { vr[q] = ((const uint4*)(rowb + (type ? 3072 : 1024)))[q]; }
  if (type == 0) {
    const int dir = tid >> 7, t = tid & 127;
    const float lg = p->in[11][dir * 8 + hd];
    rowv[tid] = dir ? -lg * (float)t : lg * (float)t;
    colv[tid] = dir ? lg * (float)t : -lg * (float)t;
    av[tid] = dir ? expf(lg * (float)(128 - t)) : expf(lg * (float)(t + 1));
  } else {
    if (w < 2) {
      const float mprev = ((const float*)(p->ws + OFF_MPREV))[(size_t)SQD(w) * NCH + SID(w)];
      mlstm_vecs<true>(gates, row0, hd, w, lane, mprev, colv + w * 128, rowv + w * 128, av + w * 128, en + w * 128, tot + w * 2);
    } else if (w == 2) {
      const int dir = lane >> 5;
      const float* nb = (const float*)(p->ws + OFF_NBUF) + ((size_t)SQD(dir) * NCH + SID(dir)) * 64;
      const int d = (lane & 31) * 2;
      npv[dir * 64 + d] = nb[d]; npv[dir * 64 + d + 1] = nb[d + 1];
    }
  }
    __builtin_amdgcn_sched_barrier(0);
    float v[32];
    raw_process(p, type, hd, 0, pos, isLat, half, 1.f, qr, v);
    store32bf(sQ + t * LDT + half * 32, v);
    __builtin_amdgcn_sched_barrier(0);
    {
      const uint4* s0 = (const uint4*)((const bf16_t*)(p->ws + OFF_SBUF) + ((size_t)SQD(0) * NCH + SID(0)) * 4096 + d * 64 + e0);
      const uint4* s1 = (const uint4*)((const bf16_t*)(p->ws + OFF_SBUF) + ((size_t)SQD(1) * NCH + SID(1)) * 4096 + d * 64 + e0);
      cx00 = s0[0]; cx01 = s0[1]; cx10 = s1[0]; cx11 = s1[1];
    }
    __builtin_amdgcn_sched_barrier(0);
    raw_process(p, type, hd, 1, pos, isLat, half, 0.125f, kr, v);
    store32bf(sK + t * LDT + half * 32, v);
    __builtin_amdgcn_sched_barrier(0);
#pragma unroll
    for (int q = 0; q < 4; ++q) {
      const unsigned uu[4] = {vr[q].x, vr[q].y, vr[q].z, vr[q].w};
#pragma unroll
      for (int j = 0; j < 4; ++j) {
        sVT[(half * 32 + q * 8 + 2 * j) * LDV + t] = (bf16_t)(uu[j] & 0xffffu);
        sVT[(half * 32 + q * 8 + 2 * j + 1) * LDV + t] = (bf16_t)(uu[j] >> 16);
      }
    }
    {
      uint4* dp0 = (uint4*)(sCT + d * LDT + e0);
      uint4* dp1 = (uint4*)(sCT + 64 * LDT + d * LDT + e0);
      dp0[0] = cx00; dp0[1] = cx01; dp1[0] = cx10; dp1[1] = cx11;
    }
  }
  __syncthreads();
  const int r = lane & 31, h = lane >> 5;
  bf16x8 qa[4];
#pragma unroll
  for (int ks = 0; ks < 4; ++ks) qa[ks] = *(const bf16x8*)&sQ[(w * 32 + r) * LDT + ks * 16 + h * 8];
  f32x16 accS[4];
#pragma unroll
  for (int tn = 0; tn < 4; ++tn) {
#pragma unroll
    for (int i = 0; i < 16; ++i) accS[tn][i] = 0.f;
#pragma unroll
    for (int ks = 0; ks < 4; ++ks) {
      bf16x8 kk = *(const bf16x8*)&sK[(tn * 32 + r) * LDT + ks * 16 + h * 8];
      accS[tn] = MFMA32(kk, qa[ks], accS[tn]);
    }
  }
  if (type == 1) {
    const int dir = tid >> 7, t = tid & 127;
    float s = 0.f;
    for (int q = 0; q < 8; ++q) {
      float x[8]; load8bf(sQ + t * LDT + q * 8, x);
#pragma unroll
      for (int j = 0; j < 8; ++j) s += x[j] * npv[dir * 64 + q * 8 + j];
    }
    qn[tid] = s;
  }
  __syncthreads();
  f32x16 accSum[2];
#pragma unroll
  for (int i = 0; i < 16; ++i) { accSum[0][i] = 0.f; accSum[1][i] = 0.f; }
  const int ws = wv & 3;
  const int tq = w * 32 + r;
#pragma unroll 1
  for (int dir = 0; dir < 2; ++dir) {
    const float* cvp = colv + dir * 128;
    const bf16_t* ct = sCT + dir * 64 * LDT;
    const float rvt = rowv[dir * 128 + tq];
    const float at = av[dir * 128 + tq];
    f32x16 accD[2];
#pragma unroll
    for (int i = 0; i < 16; ++i) { accD[0][i] = 0.f; accD[1][i] = 0.f; }
#pragma unroll
    for (int ks = 0; ks < 4; ++ks) {
      bf16x8 c0 = *(const bf16x8*)&ct[r * LDT + ks * 16 + h * 8];
      bf16x8 c1 = *(const bf16x8*)&ct[(32 + r) * LDT + ks * 16 + h * 8];
      accD[0] = MFMA32(c0, qa[ks], accD[0]);
      accD[1] = MFMA32(c1, qa[ks], accD[1]);
    }
#pragma unroll
    for (int i = 0; i < 16; ++i) { accD[0][i] *= at; accD[1][i] *= at; }
    float lsum = 0.f;
    int tl = tq; asm volatile("" : "+v"(tl));
#pragma unroll
    for (int tn = 0; tn < 4; ++tn) {
      const bool dead = dir ? (tn < ws) : (tn > ws);
      if (dead) continue;
      float pe[16];
      if (tn == ws) {
#pragma unroll
        for (int i = 0; i < 16; ++i) {
          const int s = tn * 32 + crow(i, h);
          const bool ok = dir ? (s >= tl) : (s <= tl);
          pe[i] = ok ? accS[tn][i] * __expf(rvt + cvp[s]) : 0.f;
        }
      } else {
#pragma unroll
        for (int i = 0; i < 16; ++i) pe[i] = accS[tn][i] * __expf(rvt + cvp[tn * 32 + crow(i, h)]);
      }
#pragma unroll
      for (int i = 0; i < 16; ++i) lsum += pe[i];
#pragma unroll
      for (int st = 0; st < 2; ++st) {
        uint4 pk;
        pk.x = pack2(pe[8 * st + 0], pe[8 * st + 1]); pk.y = pack2(pe[8 * st + 2], pe[8 * st + 3]);
        pk.z = pack2(pe[8 * st + 4], pe[8 * st + 5]); pk.w = pack2(pe[8 * st + 6], pe[8 * st + 7]);
        const bf16x8 pb = __builtin_bit_cast(bf16x8, pk);
#pragma unroll
        for (int et = 0; et < 2; ++et) {
          const bf16_t* vp = sVT + (et * 32 + r) * LDV + tn * 32 + 16 * st + 4 * h;
          const s16x4 lo = *(const s16x4*)vp, hi = *(const s16x4*)(vp + 8);
          const bf16x8 va = __builtin_shufflevector(lo, hi, 0, 1, 2, 3, 4, 5, 6, 7);
          accD[et] = MFMA32(va, pb, accD[et]);
        }
      }
      __builtin_amdgcn_sched_barrier(0);
    }
    float inv = 1.f;
    if (type == 1) {
      const float rs = lsum + shfl_lane(lsum, lane ^ 32);
      const float d0 = rs + at * qn[dir * 128 + tq];
      inv = __builtin_amdgcn_rcpf(fmaxf(fabsf(d0), en[dir * 128 + tq]));
    }
#pragma unroll
    for (int i = 0; i < 16; ++i) { accSum[0][i] += accD[0][i] * inv; accSum[1][i] += accD[1][i] * inv; }
  }
  {
    const int tg = otid(wv);
    const uint4* gp = (const uint4*)(P0 + (size_t)(row0 + (tg >> 1)) * 4096 + (type ? 3584 : 1536) + hd * 64 + (tg & 1) * 32);
#pragma unroll
    for (int q = 0; q < 4; ++q) gr[q] = gp[q];
  }
#pragma unroll
  for (int i = 0; i < 16; ++i) {
    sO[tq * 65 + crow(i, h)] = accSum[0][i];
    sO[tq * 65 + 32 + crow(i, h)] = accSum[1][i];
  }
  __syncthreads();
  {
    const int t = tid >> 1, half = tid & 1;
    float o[32], g[32];
    float ss = 0.f;
#pragma unroll
    for (int i = 0; i < 32; ++i) { o[i] = sO[t * 65 + half * 32 + i]; ss += o[i] * o[i]; }
    ss += shx<1>(ss);
    const float rstd = rsqrtf(ss * (1.f / 64.f) + 1e-6f);
#pragma unroll
    for (int q = 0; q < 4; ++q) unpack8(gr[q], g + q * 8);
    const float* nw = (type ? p->in[16] : p->in[12]) + hd * 64 + half * 32;
#pragma unroll
    for (int i = 0; i < 32; ++i) {
      const float gt = type ? sigmoidf_(g[i]) : siluf_(g[i]);
      o[i] = o[i] * rstd * nw[i] * gt;
    }
    store32bf(MRG + (size_t)(row0 + t) * 1024 + type * 512 + hd * 64 + half * 32, o);
  }
  __syncthreads();
}

DI void load_qk_l1(const bf16_t* __restrict__ src, const float* __restrict__ nw, const float* __restrict__ ropeRow, bool doRope, int half, float scale, float* v) {
  load32bf(src, v);
  float ss = 0.f;
#pragma unroll
  for (int i = 0; i < 32; ++i) ss += v[i] * v[i];
  ss += shx<1>(ss);
  const float rstd = rsqrtf(ss * (1.f / 64.f) + 1e-6f);
#pragma unroll
  for (int q = 0; q < 8; ++q) {
    const float4 w4 = *(const float4*)(nw + half * 32 + q * 4);
    v[q * 4 + 0] *= rstd * w4.x; v[q * 4 + 1] *= rstd * w4.y; v[q * 4 + 2] *= rstd * w4.z; v[q * 4 + 3] *= rstd * w4.w;
  }
  if (doRope) rope32(v, half, ropeRow);
#pragma unroll
  for (int i = 0; i < 32; ++i) v[i] *= scale;
}


DI void phase_attn(int wv, KP p, int item, char* smem) {
  const int tid = otid(wv), lane = tid & 63, w = tid >> 6, r = lane & 31, h = lane >> 5;
  const int qb = item & 63, hq = (item >> 6) & 15, b = item >> 10;
  const int hkv = hq >> 2;
  constexpr int BUF_ELEMS = 128 * LDT + 64 * LDV;
  bf16_t* sbase = (bf16_t*)smem;
  const bf16_t* QKV = (const bf16_t*)(p->ws + OFF_QKV);
  const int t2 = tid >> 1, half = tid & 1;
  uint4 kr0 = make_uint4(0, 0, 0, 0), kr1 = kr0, kr2 = kr0, kr3 = kr0, vr0 = kr0, vr1 = kr0, vr2 = kr0, vr3 = kr0;
#define TILE_VALID(kt) ((kt) >= 3 || (qb - 1 + (kt) >= 0 && qb - 1 + (kt) < 64))
#define TILE_ROW0(kt) ((kt) < 3 ? b * SEQ + (qb - 1 + (kt)) * 128 : NLAT + b * LC + ((kt) - 3) * 128)
#define TILE_LOAD(kt) do { const uint4* kp_ = (const uint4*)(QKV + (size_t)(TILE_ROW0(kt) + t2) * 1536 + 1024 + hkv * 64 + half * 32); \
    kr0 = kp_[0]; kr1 = kp_[1]; kr2 = kp_[2]; kr3 = kp_[3]; vr0 = kp_[32]; vr1 = kp_[33]; vr2 = kp_[34]; vr3 = kp_[35]; } while (0)
#define V_SCATTER(q, vr) do { \
    sVT[(half * 32 + (q) * 8 + 0) * LDV + t2] = (bf16_t)((vr).x & 0xffffu); sVT[(half * 32 + (q) * 8 + 1) * LDV + t2] = (bf16_t)((vr).x >> 16); \
    sVT[(half * 32 + (q) * 8 + 2) * LDV + t2] = (bf16_t)((vr).y & 0xffffu); sVT[(half * 32 + (q) * 8 + 3) * LDV + t2] = (bf16_t)((vr).y >> 16); \
    sVT[(half * 32 + (q) * 8 + 4) * LDV + t2] = (bf16_t)((vr).z & 0xffffu); sVT[(half * 32 + (q) * 8 + 5) * LDV + t2] = (bf16_t)((vr).z >> 16); \
    sVT[(half * 32 + (q) * 8 + 6) * LDV + t2] = (bf16_t)((vr).w & 0xffffu); sVT[(half * 32 + (q) * 8 + 7) * LDV + t2] = (bf16_t)((vr).w >> 16); } while (0)
  if (TILE_VALID(0)) TILE_LOAD(0);
  bf16x8 qa[4];
  {
    const bf16_t* qp = QKV + (size_t)(b * SEQ + qb * 128 + w * 32 + r) * 1536 + hq * 64 + h * 8;
#pragma unroll
    for (int ks = 0; ks < 4; ++ks) qa[ks] = *(const bf16x8*)(qp + ks * 16);
  }
  float wqm = 0.f, wkm = 0.f;
  {
    const float a_ = fabsf(p->in[19][lane]), b_ = fabsf(p->in[20][lane]);
    wqm = row16_max(a_); wqm = fmaxf(wqm, swz<16>(wqm)); wqm = fmaxf(wqm, shfl_lane(wqm, lane ^ 32));
    wkm = row16_max(b_); wkm = fmaxf(wkm, swz<16>(wkm)); wkm = fmaxf(wkm, shfl_lane(wkm, lane ^ 32));
  }
  const float snk2 = p->in[21][hq] * 1.44269504f;
  const float cshift = fmaxf(8.f * 1.44269504f * wqm * wkm, snk2);
  float lsum;
  f32x16 accO[2];
  float zero_ = 0.f, ninit = -cshift;
  asm volatile("" : "+v"(zero_), "+v"(ninit));
  lsum = zero_;
#pragma unroll
  for (int i = 0; i < 16; ++i) { accO[0][i] = zero_; accO[1][i] = zero_; }
#pragma unroll 1
  for (int kt = 0; kt < 5; ++kt) {
    const bool valid = TILE_VALID(kt);
    bf16_t* sK = sbase + (kt & 1) * BUF_ELEMS;
    bf16_t* sVT = sK + 128 * LDT;
    if (valid) {
      uint4* kd = (uint4*)(sK + t2 * LDT + half * 32);
      kd[0] = kr0; kd[1] = kr1; kd[2] = kr2; kd[3] = kr3;
      V_SCATTER(0, vr0); V_SCATTER(1, vr1); V_SCATTER(2, vr2); V_SCATTER(3, vr3);
    }
    __syncthreads();
    if (kt + 1 < 5 && TILE_VALID(kt + 1)) TILE_LOAD(kt + 1);
    if (valid) {
      const bool edge = (kt == 0 || kt == 2);
      const int ws = wv & 3;
      int tl = w * 32 + r; asm volatile("" : "+v"(tl));
#pragma unroll 1
      for (int tn = 0; tn < 4; ++tn) {
        if ((kt == 0 && tn < ws) || (kt == 2 && tn > ws)) continue;
        const bool diag = edge && tn == ws;
        f32x16 acc;
#pragma unroll
        for (int i = 0; i < 16; ++i) acc[i] = ninit;
#pragma unroll
        for (int ks = 0; ks < 4; ++ks) {
          bf16x8 kk = *(const bf16x8*)&sK[(tn * 32 + r) * LDT + ks * 16 + h * 8];
          acc = MFMA32(kk, qa[ks], acc);
        }
        float pe[16];
        if (diag) {
#pragma unroll
          for (int i = 0; i < 16; ++i) {
            const int sl = tn * 32 + crow(i, h);
            const bool ok = (kt == 0) ? (sl >= tl) : (sl <= tl);
            pe[i] = ok ? __builtin_amdgcn_exp2f(acc[i]) : 0.f;
          }
        } else {
#pragma unroll
          for (int i = 0; i < 16; ++i) pe[i] = __builtin_amdgcn_exp2f(acc[i]);
        }
        float s8 = 0.f;
#pragma unroll
        for (int i = 0; i < 16; ++i) s8 += pe[i];
        lsum += s8;
#pragma unroll
        for (int st = 0; st < 2; ++st) {
          uint4 pk;
          pk.x = pack2(pe[8 * st + 0], pe[8 * st + 1]); pk.y = pack2(pe[8 * st + 2], pe[8 * st + 3]);
          pk.z = pack2(pe[8 * st + 4], pe[8 * st + 5]); pk.w = pack2(pe[8 * st + 6], pe[8 * st + 7]);
          const bf16x8 pb = __builtin_bit_cast(bf16x8, pk);
#pragma unroll
          for (int et = 0; et < 2; ++et) {
            const bf16_t* vp = sVT + (et * 32 + r) * LDV + tn * 32 + 16 * st + 4 * h;
            const s16x4 lo = *(const s16x4*)vp, hi = *(const s16x4*)(vp + 8);
            const bf16x8 va = __builtin_shufflevector(lo, hi, 0, 1, 2, 3, 4, 5, 6, 7);
            accO[et] = MFMA32(va, pb, accO[et]);
          }
        }
      }
    }
  }
  __syncthreads();
#undef TILE_VALID
#undef TILE_ROW0
#undef TILE_LOAD
#undef V_SCATTER
  const float ltot = lsum + shfl_lane(lsum, lane ^ 32);
  const float inv = 1.f / (ltot + __builtin_amdgcn_exp2f(snk2 - cshift));
  bf16_t* dst = (bf16_t*)(p->ws + OFF_AO) + (size_t)(b * SEQ + qb * 128 + w * 32 + r) * 1024 + hq * 64 + 4 * h;
#pragma unroll
  for (int et = 0; et < 2; ++et)
#pragma unroll
    for (int g = 0; g < 4; ++g) {
      uint2 o;
      o.x = pack2(accO[et][4 * g] * inv, accO[et][4 * g + 1] * inv);
      o.y = pack2(accO[et][4 * g + 2] * inv, accO[et][4 * g + 3] * inv);
      *(uint2*)(dst + et * 32 + 8 * g) = o;
    }
}

#define XB_TMO      128
#define XB_XCNT(j)  (256  + 64 * (j))
#define XB_XSUB(j)  (1280 + 64 * (j))
#define XB_XGEN(j)  (2304 + 64 * (j))
#define XB_TOP      3328
#define XB_TOPGEN   3392
#define XCD_BAR_WORDS 3456
#define XB_SPIN_CAP (1u << 18)
DI unsigned xb_ld(unsigned* p) { return __hip_atomic_load(p, __ATOMIC_RELAXED, __HIP_MEMORY_SCOPE_AGENT); }
DI unsigned xb_add(unsigned* p, unsigned v) { return __hip_atomic_fetch_add(p, v, __ATOMIC_RELAXED, __HIP_MEMORY_SCOPE_AGENT); }
DI unsigned xb_xcc_id() { return (unsigned)__builtin_amdgcn_s_getreg((3 << 11) | 20) & 0xFu; }
#define XB_SPIN(cond, bar) do { unsigned _sp = 0; while (cond) { __builtin_amdgcn_s_sleep(1); \
    if ((++_sp & 255u) == 0u) { if (xb_ld(&(bar)[XB_TMO])) break; if (_sp > XB_SPIN_CAP) { atomicAdd(&(bar)[XB_TMO], 1u); break; } } } } while (0)
DI void xcd_barrier_complete(unsigned* bar, unsigned x, unsigned& nloc, unsigned& nx) {
  const unsigned G = gridDim.x;
  unsigned sum, cnt, mine, sp = 0u;
  for (;;) {
    sum = 0u; cnt = 0u; mine = 0u;
#pragma unroll
    for (unsigned j = 0; j < 16; ++j) { const unsigned c = xb_ld(&bar[XB_XCNT(j)]); sum += c; cnt += (c > 0u) ? 1u : 0u; mine = (j == x) ? c : mine; }
    if (sum == G) break;
    __builtin_amdgcn_s_sleep(1);
    if ((++sp & 255u) == 0u) { if (xb_ld(&bar[XB_TMO])) break; if (sp > XB_SPIN_CAP) { atomicAdd(&bar[XB_TMO], 1u); break; } }
  }
  nloc = mine > 0u ? mine : 1u; nx = cnt > 0u ? cnt : 1u;
}
DI void xcd_barrier(int wv, unsigned* bar, volatile unsigned* st) {
  asm volatile("s_waitcnt vmcnt(0)" ::: "memory");
  __syncthreads();
  if (wv == 0 && lane_id() == 0) {
    const unsigned x = xb_xcc_id();
    __builtin_amdgcn_s_waitcnt(0);
    unsigned nloc = st[0], nx = st[1];
    if (nloc == 0u) { xcd_barrier_complete(bar, x, nloc, nx); st[0] = nloc; st[1] = nx; }
    const unsigned old = xb_add(&bar[XB_XSUB(x)], 1u);
    const unsigned gen = old / nloc;
    if (old + 1u == (gen + 1u) * nloc) {
      __builtin_amdgcn_fence(__ATOMIC_RELEASE, "agent");
      asm volatile("s_waitcnt vmcnt(0)" ::: "memory");
      const unsigned og = xb_add(&bar[XB_TOP], 1u);
      const unsigned tg = og / nx;
      if (og + 1u == (tg + 1u) * nx) xb_add(&bar[XB_TOPGEN], 1u);
      else XB_SPIN(xb_ld(&bar[XB_TOPGEN]) == tg, bar);
      __builtin_amdgcn_fence(__ATOMIC_ACQUIRE, "agent");
      xb_add(&bar[XB_XGEN(x)], 1u);
      asm volatile("s_waitcnt vmcnt(0)" ::: "memory");
    } else {
      XB_SPIN(xb_ld(&bar[XB_XGEN(x)]) == gen, bar);
      __builtin_amdgcn_fence(__ATOMIC_ACQUIRE, "agent");
      asm volatile("s_waitcnt vmcnt(0)" ::: "memory");
    }
  }
  __syncthreads();
}

constexpr int N_PHASES = 17;

#define DEFERRED_TR(FIRST_IDLE, BASE, COUNT, PER) if (G == 256 && B0 >= (FIRST_IDLE)) { for (int j_ = 0; j_ < (PER); ++j_) { const int d_ = (B0 - (FIRST_IDLE)) + (256 - (FIRST_IDLE)) * j_; \
    if (d_ < (COUNT)) { const int it = 2 * ((BASE) + d_) + hb; phase_prep_tr(wv, p, it, sm); } } }
#define PAIR_LOOP(NITEMS, CALL) for (int pr = B0; pr < (NITEMS) / 2; pr += G) { const int it = 2 * pr + hb; CALL; }

DI void run_phase(int wv, KP p, int ph, char* smem) {
  asm volatile("" : "+s"(p));
  int G = gridDim.x, B0 = blockIdx.x;
  asm volatile("" : "+s"(G), "+s"(B0));
  const int hb = wv >> 2;
  char* sm = smem + hb * HALF_SMEM;
  const float* mod0 = (const float*)(p->ws + OFF_MOD);
  const float* mod1 = mod0 + 3 * 6144;
  bf16_t* HB = (bf16_t*)p->out;
  float* X = (float*)(p->ws + OFF_X);
  float* XC = (float*)(p->ws + OFF_XC);
  bf16_t* ACT = (bf16_t*)(p->ws + OFF_ACT);
  EpiArgs ea{};
  switch (ph) {
    case 0:
      if (G == 256) { for (int pr = 640 + B0; pr < N_PREP_TR / 2; pr += G) { const int it = 2 * pr + hb; phase_prep_tr(wv, p, it, sm); } }
      else { PAIR_LOOP(N_PREP_TR, phase_prep_tr(wv, p, it, sm)); }
      for (int pr = G - 1 - B0; pr < 384 / 2; pr += G) { const int it = 2 * pr + hb; prep_mod(wv, p, it, (float*)sm); }
      for (int pr = G - 1 - B0 - 192; pr >= 0 && pr < 64 / 2; pr += G) { const int it = 2 * pr + hb; prep_rope(wv, p, it); }
      break;
    case 1:
      for (int it = B0; it < MROWS / 16; it += G) norm_mod_item(wv, p->in[0], p->in[2], p->in[6], mod0, 0, HB, it, XC);
      break;
    case 2:
      ea.obf = (bf16_t*)(p->ws + OFF_P0); ea.of32 = (float*)(p->ws + OFF_GATES); ea.bias = p->in[15];
      gemm_phase<EPI_P0, false>(wv, HB, (const bf16_t*)(p->ws + OFF_WIN0), MROWS, 4352, 1024, ea, smem);
      DEFERRED_TR(98, 0, 316, 2);
      break;
    case 3:
      PAIR_LOOP(2 * 16 * NCH, phase_kvlocal(wv, p, it, sm));
      DEFERRED_TR(32, 316, 224, 1);
      break;
    case 4:
      PAIR_LOOP(64 * 17, phase_scan(wv, p, it));
      break;
    case 5:
      PAIR_LOOP(2 * 16 * NCH, phase_chunkout(wv, p, it, sm, HB));
      DEFERRED_TR(32, 540, 100, 1);
      break;
    case 6:
      ea.of32 = X; ea.of32c = XC; ea.resLat = p->in[0]; ea.resCtx = p->in[2]; ea.gvec = mod0 + 2048;
      gemm_phase<EPI_RES, true>(wv, HB, (const bf16_t*)(p->ws + OFF_WOUT0), MROWS, 1024, 1024, ea, smem, NLAT, 4);
      break;
    case 7:
      for (int it = B0; it < MROWS / 16; it += G) norm_mod_item(wv, X, XC, p->in[6] + 1024, mod0, 3072, HB, it);
      break;
    case 8:
      ea.obf = ACT; ea.ldo = DFF;
      gemm_phase<EPI_SWIGLU, false>(wv, HB, (const bf16_t*)(p->ws + OFF_WFI), MROWS, 5632, 1024, ea, smem);
      break;
    case 9:
      ea.of32 = X; ea.of32c = XC; ea.resLat = X; ea.resCtx = XC; ea.gvec = mod0 + 5120;
      gemm_phase<EPI_RES, true>(wv, ACT, (const bf16_t*)(p->ws + OFF_WFO), MROWS, 1024, DFF, ea, smem, NLAT, 11);
      break;
    case 10:
      for (int it = B0; it < MROWS / 16; it += G) norm_mod_item(wv, X, XC, p->in[6] + 2048, mod1, 0, HB, it);
      break;
    case 11:
      ea.obf = (bf16_t*)(p->ws + OFF_QKV); ea.ldo = 1536; ea.bias = p->in[19]; ea.gvec = p->in[20]; ea.resLat = (const float*)(p->ws + OFF_ROPE);
      gemm_phase<EPI_QKV, false>(wv, HB, (const bf16_t*)(p->ws + OFF_WAI), MROWS, 1536, 1024, ea, smem);
      break;
    case 12:
      PAIR_LOOP(2048, phase_attn(wv, p, it, sm));
      break;
    case 13:
      ea.of32 = X; ea.resLat = X; ea.resCtx = X; ea.gvec = mod1 + 2048;
      gemm_phase<EPI_RES, false>(wv, (const bf16_t*)(p->ws + OFF_AO), (const bf16_t*)(p->ws + OFF_WAO), NLAT, 1024, 1024, ea, smem);
      break;
    case 14:
      for (int it = B0; it < NLAT / 16; it += G) norm_mod_item(wv, X, X, p->in[6] + 3072, mod1, 3072, HB, it);
      break;
    case 15:
      ea.obf = ACT; ea.ldo = DFF;
      gemm_phase<EPI_SWIGLU, false>(wv, HB, (const bf16_t*)(p->ws + OFF_WFI) + (size_t)5632 * 1024, NLAT, 5632, 1024, ea, smem);
      break;
    case 16:
      ea.of32 = p->out; ea.resLat = X; ea.resCtx = X; ea.gvec = mod1 + 5120;
      gemm_phase<EPI_RES, false>(wv, ACT, (const bf16_t*)(p->ws + OFF_WFO) + (size_t)1024 * DFF, NLAT, 1024, DFF, ea, smem);
      break;
    default: break;
  }
}

#ifndef CG_SYNCS
#define CG_SYNCS 0
#endif
__global__ void __launch_bounds__(NTHR, 2) mega_fwd(Params pargs, int ph_lo, int ph_hi) {
  extern __shared__ __attribute__((aligned(16))) char smem[];
  KP p = (KP)__builtin_amdgcn_kernarg_segment_ptr();
  const int wv = __builtin_amdgcn_readfirstlane((int)(threadIdx.x >> 6));
  volatile unsigned* st = (volatile unsigned*)(smem + SMEM_BYTES);
  {
    unsigned* bar = (unsigned*)(p->ws + OFF_BAR);
    if (wv == 0 && lane_id() == 0) { st[0] = 0u; st[1] = 0u; (void)xb_add(&bar[XB_XCNT(xb_xcc_id())], 1u); }
    __syncthreads();
  }
  if (ph_hi < 0) cg::this_grid().sync();
  for (int ph = ph_lo; ph < ph_hi; ++ph) {
    run_phase(wv, p, ph, smem);
#if REPEAT_MASK
    if ((REPEAT_MASK >> ph) & 1) { xcd_barrier(wv, (unsigned*)(p->ws + OFF_BAR), st); run_phase(wv, p, ph, smem); }
#endif
    if (ph + 1 < ph_hi) {
      if (ph - ph_lo < CG_SYNCS) cg::this_grid().sync();
      else xcd_barrier(wv, (unsigned*)(p->ws + OFF_BAR), st);
    }
#if EXTRA_SYNCS
    if (ph == 0) { for (int e = 0; e < EXTRA_SYNCS; ++e) xcd_barrier(wv, (unsigned*)(p->ws + OFF_BAR), st); }
#endif
  }
}

extern "C" void kernel_launch(void* const* d_in, const int* in_sizes, int n_in, void* d_out, int out_size, void* d_ws, size_t ws_size, hipStream_t stream) {
  static int grid_blocks = 0;
  if (grid_blocks == 0) {
    if (n_in != 22 || out_size != NLAT * DM || ws_size < WS_END)
      fprintf(stderr, "kernel_launch: unexpected shapes n_in %d out %d ws %zu (need %zu)\n", n_in, out_size, ws_size, (size_t)WS_END);
    int dev = 0, cus = 0, per_cu = 0;
    (void)hipGetDevice(&dev);
    (void)hipDeviceGetAttribute(&cus, hipDeviceAttributeMultiprocessorCount, dev);
    (void)hipFuncSetAttribute((const void*)mega_fwd, hipFuncAttributeMaxDynamicSharedMemorySize, LDS_TOTAL);
    (void)hipOccupancyMaxActiveBlocksPerMultiprocessor(&per_cu, (const void*)mega_fwd, NTHR, LDS_TOTAL);
    if (per_cu < 1) fprintf(stderr, "kernel_launch: occupancy query reports %d blocks per CU\n", per_cu);
    grid_blocks = cus;
    fprintf(stderr, "kernel_launch: cus %d per_cu %d grid %d\n", cus, per_cu, grid_blocks);
  }
  Params p{};
  for (int i = 0; i < 22; ++i) p.in[i] = (const float*)d_in[i];
  p.out = (float*)d_out;
  p.ws = (char*)d_ws;
  (void)hipMemsetAsync((char*)d_ws + OFF_BAR, 0, 16384, stream);
#if MULTI_LAUNCH
  for (int ph = 0; ph < N_PHASES; ++ph) {
    int lo = ph, hi = ph + 1;
    hipLaunchKernelGGL(mega_fwd, dim3(grid_blocks), dim3(NTHR), LDS_TOTAL, stream, p, lo, hi);
  }
#else
  int lo = 0, hi = N_PHASES;
  void* args[] = {&p, &lo, &hi};
  hipError_t e = hipLaunchCooperativeKernel((const void*)mega_fwd, dim3(grid_blocks), dim3(NTHR), args, LDS_TOTAL, stream);
  if (e != hipSuccess) fprintf(stderr, "cooperative launch failed: %s (grid %d)\n", hipGetErrorString(e), grid_blocks);
#endif
}
```
